# Optimizing an MI355X kernel written in HIP

```python
import math
import jax
import jax.numpy as jnp
from jax import lax
import numpy as np

D_MODEL = 1024
BATCH = 16
SEQ = 2048
DEPTH = 2

GRID_W = 64
CTX_LEN = 256
N_MOD = 6
EPS = 1e-6
ROPE_BASE = 10000.0
ATTN_BLOCK = 128

SWA_HEADS = 4
SWA_KV_HEADS = 2
SWA_HEAD_DIM = 64
SWA_WINDOW = 128

GDN_HEADS = 4
GDN_HEAD_DIM = 128
GDN_CONV = 5
GDN_CHUNK = 64

MLA_HEADS = 4
MLA_Q_RANK = 256
MLA_KV_RANK = 128
MLA_NOPE = 64
MLA_ROPE = 32
MLA_V = 64
MLA_QK = MLA_NOPE + MLA_ROPE

N_EXPERTS = 32
TOP_K = 4
D_EXPERT = 1024
SWIGLU_LIMIT = 7.0
SWIGLU_ALPHA = 1.702
MOE_BLOCK = 256

SWA_Q = SWA_HEADS * SWA_HEAD_DIM
SWA_KV = SWA_KV_HEADS * SWA_HEAD_DIM
GDN_W = GDN_HEADS * GDN_HEAD_DIM
MLA_O = MLA_HEADS * MLA_V
D_MIX = SWA_Q + GDN_W + MLA_O
IN_SPLITS = (SWA_Q, SWA_KV, SWA_KV, GDN_W, GDN_W, GDN_W, GDN_W, 2 * GDN_HEADS, 2 * GDN_HEADS, MLA_Q_RANK, MLA_KV_RANK, MLA_ROPE)
N_IN = sum(IN_SPLITS)

kernel_name = 'hybrid_swa_gdn_mla_moe_dit'

F32 = jnp.float32


def rms_norm(x, gain):
    xf = x.astype(F32)
    y = xf * lax.rsqrt(jnp.mean(xf * xf, axis=-1, keepdims=True) + EPS)
    return (y * gain.astype(F32)).astype(x.dtype)


def l2_norm(x):
    xf = x.astype(F32)
    return xf * lax.rsqrt(jnp.sum(xf * xf, axis=-1, keepdims=True) + EPS)


def modulate(x, gain, shift, scale):
    return rms_norm(x, gain) * (1 + scale) + shift


def axial_rope_tables(n_lat, rot_dim):
    rows = n_lat // GRID_W
    t = jnp.arange(rows * GRID_W)
    row = (t // GRID_W).astype(F32)
    col = (t % GRID_W).astype(F32)
    n_freq = rot_dim // 4
    freq = ROPE_BASE ** (-jnp.arange(n_freq, dtype=F32) / n_freq)
    ang = jnp.stack([row[:, None] * freq, col[:, None] * freq], axis=1)
    return jnp.cos(ang), jnp.sin(ang)


def apply_axial_rope(x, cos, sin):
    b, n, h, r = x.shape
    xr = x.astype(F32).reshape(b, n, h, 2, 2, r // 4)
    x1, x2 = xr[..., 0, :], xr[..., 1, :]
    cs, sn = cos[None, :, None], sin[None, :, None]
    out = jnp.stack([x1 * cs - x2 * sn, x2 * cs + x1 * sn], axis=-2)
    return out.reshape(b, n, h, r).astype(x.dtype)


def swa_latent(q, k, v, kc, vc, sink):
    b, s, hq, dh = q.shape
    hkv = k.shape[2]
    grp = hq // hkv
    nb = s // ATTN_BLOCK
    nw = 3 * ATTN_BLOCK
    scale = dh ** -0.5
    qb = q.reshape(b, nb, ATTN_BLOCK, hkv, grp, dh)
    pad = ((0, 0), (ATTN_BLOCK, ATTN_BLOCK), (0, 0), (0, 0))
    kp = jnp.pad(k, pad).reshape(b, nb + 2, ATTN_BLOCK, hkv, dh)
    vp = jnp.pad(v, pad).reshape(b, nb + 2, ATTN_BLOCK, hkv, dh)
    kw = jnp.concatenate([kp[:, :-2], kp[:, 1:-1], kp[:, 2:]], axis=2)
    vw = jnp.concatenate([vp[:, :-2], vp[:, 1:-1], vp[:, 2:]], axis=2)
    q_off = jnp.arange(ATTN_BLOCK)
    k_off = jnp.arange(nw) - ATTN_BLOCK
    key_pos = jnp.arange(nb)[:, None] * ATTN_BLOCK + k_off[None, :]
    in_band = jnp.abs(k_off[None, :] - q_off[:, None]) <= SWA_WINDOW
    in_seq = (key_pos >= 0) & (key_pos < s)
    valid = in_band[None] & in_seq[:, None, :]
    s_win = jnp.einsum('bnqhgd,bnkhd->bnhgqk', qb, kw, preferred_element_type=F32) * scale
    s_win = jnp.where(valid[None, :, None, None], s_win, -jnp.inf)
    s_ctx = jnp.einsum('bnqhgd,bchd->bnhgqc', qb, kc, preferred_element_type=F32) * scale
    s_sink = jnp.broadcast_to(sink.astype(F32).reshape(hkv, grp)[:, :, None, None], s_win.shape[:-1] + (1,))
    p = jax.nn.softmax(jnp.concatenate([s_win, s_ctx, s_sink], axis=-1), axis=-1).astype(v.dtype)
    o = (jnp.einsum('bnhgqk,bnkhd->bnqhgd', p[..., :nw], vw)
         + jnp.einsum('bnhgqc,bchd->bnqhgd', p[..., nw:-1], vc))
    return o.reshape(b, s, hq * dh)


def context_attention(q, k, v, sink):
    b, n, hq, dq = q.shape
    hkv = k.shape[2]
    grp = hq // hkv
    qg = q.reshape(b, n, hkv, grp, dq)
    sc = jnp.einsum('bqhgd,bkhd->bhgqk', qg, k, preferred_element_type=F32) * dq ** -0.5
    if sink is not None:
        s_sink = jnp.broadcast_to(sink.astype(F32).reshape(hkv, grp)[:, :, None, None], sc.shape[:-1] + (1,))
        sc = jnp.concatenate([sc, s_sink], axis=-1)
    p = jax.nn.softmax(sc, axis=-1).astype(v.dtype)[..., :n]
    o = jnp.einsum('bhgqk,bkhd->bqhgd', p, v)
    return o.reshape(b, n, hq * v.shape[-1])


def dense_block_attention(q, k, v, kc, vc):
    b, s, h, dqk = q.shape
    dv = v.shape[-1]
    nb = s // ATTN_BLOCK
    scale = dqk ** -0.5
    qb = jnp.moveaxis(q.reshape(b, nb, ATTN_BLOCK, h, dqk), 1, 0)

    def attend(qi):
        sl = jnp.einsum('bqhd,bkhd->bhqk', qi, k, preferred_element_type=F32) * scale
        sc = jnp.einsum('bqhd,bchd->bhqc', qi, kc, preferred_element_type=F32) * scale
        p = jax.nn.softmax(jnp.concatenate([sl, sc], axis=-1), axis=-1).astype(v.dtype)
        return (jnp.einsum('bhqk,bkhd->bqhd', p[..., :s], v)
                + jnp.einsum('bhqc,bchd->bqhd', p[..., s:], vc))

    o = lax.map(attend, qb)
    return jnp.moveaxis(o, 0, 1).reshape(b, s, h * dv)


def short_conv(x, w):
    y = lax.conv_general_dilated(
        x, w[:, None, :].astype(x.dtype), window_strides=(1,),
        padding=[(GDN_CONV // 2, GDN_CONV // 2)],
        dimension_numbers=('NWC', 'WIO', 'NWC'), feature_group_count=x.shape[-1])
    return jax.nn.silu(y)


def gdn_chunk_scan(q, k, v, g, beta, state):
    b, n, h, _ = q.shape
    nc = n // GDN_CHUNK

    def chunks(t):
        t = t.reshape((b, nc, GDN_CHUNK, h) + t.shape[3:])
        return jnp.moveaxis(t, 3, 1)

    qc, kc, vc = chunks(q), chunks(k), chunks(v)
    gc = jnp.cumsum(chunks(g), axis=-1)
    bc = chunks(beta)
    idx = jnp.arange(GDN_CHUNK)
    incl = idx[:, None] >= idx[None, :]
    strict = idx[:, None] > idx[None, :]
    decay = jnp.exp(jnp.where(incl, gc[..., :, None] - gc[..., None, :], -jnp.inf))
    kk = jnp.einsum('bhctd,bhcid->bhcti', kc, kc)
    a_mat = jnp.where(strict, bc[..., :, None] * kk * decay, 0.0) + jnp.eye(GDN_CHUNK, dtype=F32)
    u = lax.linalg.triangular_solve(a_mat, vc * bc[..., None], left_side=True, lower=True, unit_diagonal=True)
    w = lax.linalg.triangular_solve(a_mat, kc * (bc * jnp.exp(gc))[..., None], left_side=True, lower=True, unit_diagonal=True)
    qk = jnp.einsum('bhctd,bhcid->bhcti', qc, kc) * decay
    q_dec = qc * jnp.exp(gc)[..., None]
    k_dec = kc * jnp.exp(gc[..., -1:] - gc)[..., None]
    g_end = jnp.exp(gc[..., -1])

    def step(s_prev, xs):
        u_c, w_c, qk_c, qd_c, kd_c, ge_c = xs
        v_new = u_c - jnp.einsum('bhtk,bhkv->bhtv', w_c, s_prev)
        o_c = jnp.einsum('bhtk,bhkv->bhtv', qd_c, s_prev) + jnp.einsum('bhti,bhiv->bhtv', qk_c, v_new)
        s_next = ge_c[..., None, None] * s_prev + jnp.einsum('bhtk,bhtv->bhkv', kd_c, v_new)
        return s_next, o_c

    xs = tuple(jnp.moveaxis(t, 2, 0) for t in (u, w, qk, q_dec, k_dec, g_end))
    state, o = lax.scan(step, state, xs)
    o = jnp.moveaxis(jnp.moveaxis(o, 0, 2), 1, 3)
    return o.reshape(b, n, h, o.shape[-1]), state


def orient(stream, d):
    q, k, v, g, beta = stream
    seq = (q, k, v, g[:, :, d], beta[:, :, d])
    if d == 1:
        return tuple(jnp.flip(t, axis=1) for t in seq)
    return seq


def bidirectional_gdn(lat, ctx):
    b, _, h, dk = lat[0].shape
    dv = lat[2].shape[-1]
    o_lat, o_ctx = [], []
    for d in range(2):
        state0 = jnp.zeros((b, h, dk, dv), F32)
        oc, s_ctx = gdn_chunk_scan(*orient(ctx, d), state0)
        ol, _ = gdn_chunk_scan(*orient(lat, d), s_ctx)
        if d == 1:
            oc, ol = jnp.flip(oc, axis=1), jnp.flip(ol, axis=1)
        o_lat.append(ol)
        o_ctx.append(oc)
    return o_lat[0] + o_lat[1], o_ctx[0] + o_ctx[1]


def token_mixers(p, pc, rope_a, rope_c, swa_q_norm, swa_k_norm, swa_sink, gdn_conv, gdn_a_log, gdn_dt_bias,
                 gdn_out_norm, mla_q_a_norm, mla_w_uq, mla_kv_a_norm, mla_w_ukv, mla_q_norm, mla_k_norm, with_ctx):
    b = p.shape[0]
    offsets = np.cumsum(IN_SPLITS)[:-1].tolist()
    aq, ak, av, gq, gk, gv, gz, ga, gb, cq, ckv, ckr = jnp.split(p, offsets, axis=-1)
    aq_c, ak_c, av_c, gq_c, gk_c, gv_c, gz_c, ga_c, gb_c, cq_c, ckv_c, ckr_c = jnp.split(pc, offsets, axis=-1)

    def swa_proj(q, k, v, rope):
        n = q.shape[1]
        q = rms_norm(q.reshape(b, n, SWA_HEADS, SWA_HEAD_DIM), swa_q_norm)
        k = rms_norm(k.reshape(b, n, SWA_KV_HEADS, SWA_HEAD_DIM), swa_k_norm)
        if rope is not None:
            q, k = apply_axial_rope(q, *rope), apply_axial_rope(k, *rope)
        return q, k, v.reshape(b, n, SWA_KV_HEADS, SWA_HEAD_DIM)

    qa, ka, va = swa_proj(aq, ak, av, rope_a)
    qa_c, ka_c, va_c = swa_proj(aq_c, ak_c, av_c, None)
    o_a = swa_latent(qa, ka, va, ka_c, va_c, swa_sink)

    def gdn_proj(q, k, v, a, bg):
        n = q.shape[1]
        q, k, v = jnp.split(short_conv(jnp.concatenate([q, k, v], axis=-1), gdn_conv), 3, axis=-1)
        hs = (b, n, GDN_HEADS, GDN_HEAD_DIM)
        q = l2_norm(q.reshape(hs)) * GDN_HEAD_DIM ** -0.5
        k = l2_norm(k.reshape(hs))
        v = v.reshape(hs).astype(F32)
        a = a.reshape(b, n, 2, GDN_HEADS).astype(F32)
        log_decay = -jnp.exp(gdn_a_log.astype(F32)) * jax.nn.softplus(a + gdn_dt_bias.astype(F32))
        beta = jax.nn.sigmoid(bg.reshape(b, n, 2, GDN_HEADS).astype(F32))
        return q, k, v, log_decay, beta

    def gdn_out(o, z):
        n = o.shape[1]
        gate = jax.nn.silu(z.reshape(b, n, GDN_HEADS, GDN_HEAD_DIM).astype(F32))
        return (rms_norm(o, gdn_out_norm) * gate).reshape(b, n, GDN_W).astype(p.dtype)

    ob, ob_c = bidirectional_gdn(gdn_proj(gq, gk, gv, ga, gb), gdn_proj(gq_c, gk_c, gv_c, ga_c, gb_c))
    o_b = gdn_out(ob, gz)

    def mla_proj(c_q, c_kv, k_rope, rope):
        n = c_q.shape[1]
        q = (rms_norm(c_q, mla_q_a_norm) @ mla_w_uq).reshape(b, n, MLA_HEADS, MLA_QK)
        kv = (rms_norm(c_kv, mla_kv_a_norm) @ mla_w_ukv).reshape(b, n, MLA_HEADS, MLA_NOPE + MLA_V)
        k_pe = jnp.broadcast_to(k_rope[:, :, None, :], (b, n, MLA_HEADS, MLA_ROPE))
        k = jnp.concatenate([kv[..., :MLA_NOPE], k_pe], axis=-1)
        q, k = rms_norm(q, mla_q_norm), rms_norm(k, mla_k_norm)
        if rope is not None:
            q = jnp.concatenate([q[..., :MLA_NOPE], apply_axial_rope(q[..., MLA_NOPE:], *rope)], axis=-1)
            k = jnp.concatenate([k[..., :MLA_NOPE], apply_axial_rope(k[..., MLA_NOPE:], *rope)], axis=-1)
        return q, k, kv[..., MLA_NOPE:]

    qm, km, vm = mla_proj(cq, ckv, ckr, rope_c)
    qm_c, km_c, vm_c = mla_proj(cq_c, ckv_c, ckr_c, None)
    o_c = dense_block_attention(qm, km, vm, km_c, vm_c)

    mix = jnp.concatenate([o_a, o_b, o_c], axis=-1)
    if not with_ctx:
        return mix, None
    mix_c = jnp.concatenate([context_attention(qa_c, ka_c, va_c, swa_sink), gdn_out(ob_c, gz_c),
                             context_attention(qm_c, km_c, vm_c, None)], axis=-1)
    return mix, mix_c


def clamped_swiglu(gu):
    x_glu = jnp.minimum(gu[..., ::2], SWIGLU_LIMIT)
    x_lin = jnp.clip(gu[..., 1::2], -SWIGLU_LIMIT, SWIGLU_LIMIT)
    return x_glu * jax.nn.sigmoid(SWIGLU_ALPHA * x_glu) * (x_lin + 1)


def moe_ffn(h, router_w, router_b, w_gu, b_gu, w_dn, b_dn):
    n, d = h.shape
    logits = jnp.dot(h, router_w, preferred_element_type=F32) + router_b.astype(F32)
    top_logit, top_e = lax.top_k(logits, TOP_K)
    gate = jax.nn.softmax(top_logit, axis=-1)
    nk = n * TOP_K
    e_flat = top_e.reshape(nk)
    tok_flat = jnp.arange(nk, dtype=jnp.int32) // TOP_K
    order = jnp.argsort(e_flat)
    e_sorted = e_flat[order]
    counts = jnp.bincount(e_flat, length=N_EXPERTS)
    padded = (counts + MOE_BLOCK - 1) // MOE_BLOCK * MOE_BLOCK
    pad_end = jnp.cumsum(padded)
    pad_start = pad_end - padded
    raw_start = jnp.cumsum(counts) - counts
    slot = pad_start[e_sorted] + jnp.arange(nk) - raw_start[e_sorted]
    n_blocks = -(-nk // MOE_BLOCK) + N_EXPERTS
    cap = n_blocks * MOE_BLOCK
    slot_tok = jnp.full((cap,), n, jnp.int32).at[slot].set(tok_flat[order])
    slot_gate = jnp.zeros((cap,), F32).at[slot].set(gate.reshape(nk)[order])
    block_e = jnp.minimum(jnp.searchsorted(pad_end, jnp.arange(n_blocks) * MOE_BLOCK, side='right'), N_EXPERTS - 1)
    h_pad = jnp.concatenate([h, jnp.zeros((1, d), h.dtype)], axis=0)

    def expert_block(args):
        toks, e = args
        xb = h_pad[toks]
        return clamped_swiglu(xb @ w_gu[e] + b_gu[e]) @ w_dn[e] + b_dn[e]

    y = lax.map(expert_block, (slot_tok.reshape(n_blocks, MOE_BLOCK), block_e))
    y = y.reshape(cap, d) * slot_gate[:, None].astype(y.dtype)
    return jnp.zeros((n + 1, d), y.dtype).at[slot_tok].add(y)[:n]


def setup_inputs(seed: int = 0) -> dict:
    key = jax.random.key(seed)
    ks = iter(jax.random.split(key, 32))
    L, d = DEPTH, D_MODEL

    def nrm(shape, scale):
        return jax.random.normal(next(ks), shape, F32) * scale

    def gain(shape):
        return 1.0 + nrm(shape, 0.02)

    a_log = jnp.log(jax.random.uniform(next(ks), (L, 2, GDN_HEADS), F32, 1.0, 16.0))
    dt = jnp.exp(jax.random.uniform(next(ks), (L, 2, GDN_HEADS), F32, math.log(1e-3), math.log(1e-1)))
    dt_bias = dt + jnp.log(-jnp.expm1(-dt))
    return {
        'x': nrm((BATCH, SEQ, d), 1.0),
        'c': nrm((BATCH, d), 1.0),
        'ctx': nrm((BATCH, CTX_LEN, d), 1.0),
        'c_ctx': nrm((d,), 1.0),
        'w_mod': nrm((L, d, N_MOD * d), 0.5 * d ** -0.5),
        'b_mod': nrm((L, N_MOD * d), 0.02),
        'norm1': gain((L, d)),
        'norm2': gain((L, d)),
        'w_in': nrm((L, d, N_IN), d ** -0.5),
        'w_out': nrm((L, D_MIX, d), D_MIX ** -0.5),
        'swa_q_norm': gain((L, SWA_HEAD_DIM)),
        'swa_k_norm': gain((L, SWA_HEAD_DIM)),
        'swa_sink': nrm((L, SWA_HEADS), 0.5),
        'gdn_conv': nrm((L, GDN_CONV, 3 * GDN_W), GDN_CONV ** -0.5),
        'gdn_a_log': a_log,
        'gdn_dt_bias': dt_bias,
        'gdn_out_norm': gain((L, GDN_HEAD_DIM)),
        'mla_q_a_norm': gain((L, MLA_Q_RANK)),
        'mla_w_uq': nrm((L, MLA_Q_RANK, MLA_HEADS * MLA_QK), MLA_Q_RANK ** -0.5),
        'mla_kv_a_norm': gain((L, MLA_KV_RANK)),
        'mla_w_ukv': nrm((L, MLA_KV_RANK, MLA_HEADS * (MLA_NOPE + MLA_V)), MLA_KV_RANK ** -0.5),
        'mla_q_norm': gain((L, MLA_QK)),
        'mla_k_norm': gain((L, MLA_QK)),
        'router_w': nrm((L, d, N_EXPERTS), d ** -0.5),
        'router_b': nrm((L, N_EXPERTS), 0.01),
        'exp_w_gu': nrm((L, N_EXPERTS, d, 2 * D_EXPERT), d ** -0.5),
        'exp_b_gu': nrm((L, N_EXPERTS, 2 * D_EXPERT), 0.02),
        'exp_w_dn': nrm((L, N_EXPERTS, D_EXPERT, d), D_EXPERT ** -0.5),
        'exp_b_dn': nrm((L, N_EXPERTS, d), 0.02),
    }


def reference(x, c, ctx, c_ctx, w_mod, b_mod, norm1, norm2, w_in, w_out, swa_q_norm, swa_k_norm, swa_sink,
              gdn_conv, gdn_a_log, gdn_dt_bias, gdn_out_norm, mla_q_a_norm, mla_w_uq, mla_kv_a_norm, mla_w_ukv,
              mla_q_norm, mla_k_norm, router_w, router_b, exp_w_gu, exp_b_gu, exp_w_dn, exp_b_dn):
    b, s, d = x.shape
    cl = ctx.shape[1]
    rope_a = axial_rope_tables(s, SWA_HEAD_DIM)
    rope_c = axial_rope_tables(s, MLA_ROPE)
    xc = ctx
    for l in range(DEPTH):
        with_ctx = l < DEPTH - 1
        mod = (jax.nn.silu(c) @ w_mod[l] + b_mod[l]).reshape(b, 1, N_MOD, d)
        mod_c = (jax.nn.silu(c_ctx) @ w_mod[l] + b_mod[l]).reshape(1, 1, N_MOD, d)
        h = modulate(x, norm1[l], mod[:, :, 0], mod[:, :, 1])
        hc = modulate(xc, norm1[l], mod_c[:, :, 0], mod_c[:, :, 1])
        mix, mix_c = token_mixers(h @ w_in[l], hc @ w_in[l], rope_a, rope_c, swa_q_norm[l], swa_k_norm[l],
                                  swa_sink[l], gdn_conv[l], gdn_a_log[l], gdn_dt_bias[l], gdn_out_norm[l],
                                  mla_q_a_norm[l], mla_w_uq[l], mla_kv_a_norm[l], mla_w_ukv[l], mla_q_norm[l],
                                  mla_k_norm[l], with_ctx)
        x = x + mod[:, :, 2] * (mix @ w_out[l])
        h = modulate(x, norm2[l], mod[:, :, 3], mod[:, :, 4])
        if with_ctx:
            xc = xc + mod_c[:, :, 2] * (mix_c @ w_out[l])
            hc = modulate(xc, norm2[l], mod_c[:, :, 3], mod_c[:, :, 4])
            y = moe_ffn(jnp.concatenate([h.reshape(b * s, d), hc.reshape(b * cl, d)], axis=0), router_w[l],
                        router_b[l], exp_w_gu[l], exp_b_gu[l], exp_w_dn[l], exp_b_dn[l])
            x = x + mod[:, :, 5] * y[:b * s].reshape(b, s, d)
            xc = xc + mod_c[:, :, 5] * y[b * s:].reshape(b, cl, d)
        else:
            y = moe_ffn(h.reshape(b * s, d), router_w[l], router_b[l], exp_w_gu[l], exp_b_gu[l],
                        exp_w_dn[l], exp_b_dn[l])
            x = x + mod[:, :, 5] * y.reshape(b, s, d)
    return x
```

```cpp
#include <hip/hip_runtime.h>
#include <cstdio>
#include <cstdint>
#include <cstddef>
#include <type_traits>
#ifndef MK_PER_PHASE
#define MK_PER_PHASE 0
#endif
namespace pg8 {
#define PG8_LAS __attribute__((address_space(3)))
typedef unsigned short bf16_t;
typedef short bf16x8 __attribute__((ext_vector_type(8)));
typedef float f32x4 __attribute__((ext_vector_type(4)));
typedef unsigned u32x4 __attribute__((ext_vector_type(4)));
constexpr int BM = 256, BK = 64, HALF = 128, HTB = HALF * BK * 2  , STAGE_BYTES = 8 * HTB, NXCD = 8, WGM = 8;

__host__ __device__ __forceinline__ int lds_byte(int r, int c) { const int f = r & 7; return (r >> 3) * 1024 + f * 128 + ((((c >> 3) ^ f) & 7) << 4) + (c & 7) * 2; }
__host__ __device__ __forceinline__ void stage_rc(int b, int& R, int& C) { const int pc = b / 1024, wb = b % 1024, f = wb >> 7, sc = (wb >> 4) & 7; R = pc * 8 + f; C = ((sc ^ f) << 3) + ((wb & 15) >> 1); }
__host__ __device__ __forceinline__ int perm32(int rho) { const int n = rho >> 4, i = rho & 15; return 8 * (i >> 2) + 4 * n + (i & 3); }

struct Unit { int pm, pn; };
struct Gemm { const bf16_t* A; const bf16_t* Bt; int M, N, K; };

struct StaticOrder {
    static constexpr bool GATHER = false;
    int nM, nN, nwg, G, c;
    __host__ __device__ void init(int M, int N, int G_, int c_) { nM = M / BM; nN = N / BM; nwg = nM * nN; G = G_; c = c_; }
    __host__ __device__ bool next(int i, Unit& u) const {
        const long L = (long)i * G + c; if (L >= nwg) return false;
        int wgid = (int)L; { const int q = nwg / NXCD, r = nwg % NXCD, xcd = wgid % NXCD, off = wgid / NXCD; wgid = (xcd < r ? xcd * (q + 1) : r * (q + 1) + (xcd - r) * q) + off; }
        const int nig = WGM * nN, gid = wgid / nig, fm = gid * WGM, gsz = (nM - fm) < WGM ? (nM - fm) : WGM;
        u.pm = fm + ((wgid % nig) % gsz); u.pn = (wgid % nig) / gsz; return true;
    }
    __device__ __forceinline__ void a_ready(const Unit&) const {}
    __device__ __forceinline__ void done(const Unit&) const {}
};

__device__ __forceinline__ unsigned cvt_pk_bf16(float lo, float hi) { unsigned r; asm volatile("v_cvt_pk_bf16_f32 %0, %1, %2" : "=v"(r) : "v"(lo), "v"(hi)); return r; }
typedef float f32x2 __attribute__((ext_vector_type(2)));
template <class Epi, class Sched, bool ALIGN_EPI = false, bool SP2 = false>
__device__ __forceinline__ void gemm_phase(PG8_LAS unsigned char* lds, const Gemm g, const Sched& S, const Epi& E, const int wave_s  , const int epi_reps = 1) {
    unsigned ones_ = ~0u; asm volatile("" : "+s"(ones_));
    int tid_raw = wave_s * 64 + (int)__builtin_amdgcn_mbcnt_hi(ones_, __builtin_amdgcn_mbcnt_lo(ones_, 0u)); asm volatile("" : "+v"(tid_raw));
    const int tid = tid_raw, wid = __builtin_amdgcn_readfirstlane(tid >> 6), lane = tid & 63, wr = wid >> 2, wc = wid & 3, fr = lane & 15, fq = lane >> 4;
    const int K = g.K, nt = K / BK;
    unsigned voffA[2], voffB[2];
#pragma unroll
    for (int i = 0; i < 2; ++i) { int R, C; stage_rc(tid * 16 + i * 8192, R, C); const int Rb = Epi::PERM ? ((R & ~31) + perm32(R & 31)) : R;
        voffA[i] = (unsigned)(R * K + C) * 2u; voffB[i] = (unsigned)(Rb * K + C) * 2u; }
    unsigned gA[2][2], gAn[2][2];
    const size_t kstep = (size_t)(BK * 2);
    const size_t hstep = (size_t)HALF * K * 2;
    const size_t tstep = 2 * hstep;
    const unsigned ldsw = (unsigned)wid * 1024u;
    const int aoff = lds_byte(wr * 64 + fr, fq * 8), boff = lds_byte(wc * 32 + fr, fq * 8);
#define PG8_SA(b, h) (((b) * 2 + (h)) * HTB)
#define PG8_SB(b, h) ((4 + (b) * 2 + (h)) * HTB)
#define PG8_STAGE(bufoff, gbase, voff) do { _Pragma("unroll") for (int _i = 0; _i < 2; ++_i) \
        __builtin_amdgcn_global_load_lds((const unsigned*)((const char*)(gbase) + (voff)[_i]), (PG8_LAS unsigned*)(lds + (bufoff) + ldsw + _i * 8192), 16, 0, 0); } while (0)
#define PG8_STAGE_A(bufoff, base, h, nx) do { if constexpr (Sched::GATHER) { _Pragma("unroll") for (int _i = 0; _i < 2; ++_i) \
        __builtin_amdgcn_global_load_lds((const unsigned*)((const char*)(base) + ((nx) ? gAn[h][_i] : gA[h][_i])), (PG8_LAS unsigned*)(lds + (bufoff) + ldsw + _i * 8192), 16, 0, 0); } \
    else { PG8_STAGE(bufoff, (base) + (h) * hstep, voffA); } } while (0)
#define PG8_LDA(dst, b, h) do { _Pragma("unroll") for (int m = 0; m < 4; ++m) _Pragma("unroll") for (int k = 0; k < 2; ++k) dst[m][k] = *(const PG8_LAS bf16x8*)(lds + PG8_SA(b, h) + (aoff ^ (k * 64)) + m * 2048); } while (0)
#define PG8_LDB(dst, b, h) do { _Pragma("unroll") for (int n = 0; n < 2; ++n) _Pragma("unroll") for (int k = 0; k < 2; ++k) dst[n][k] = *(const PG8_LAS bf16x8*)(lds + PG8_SB(b, h) + (boff ^ (k * 64)) + n * 2048); } while (0)
#define PG8_MMA(ai, bj, At, Bt) do { __builtin_amdgcn_s_setprio(1); _Pragma("unroll") for (int m = 0; m < 4; ++m) _Pragma("unroll") for (int n = 0; n < 2; ++n) _Pragma("unroll") for (int k = 0; k < 2; ++k) \
        acc[ai][bj][m][n] = __builtin_amdgcn_mfma_f32_16x16x32_bf16(Bt[n][k], At[m][k], acc[ai][bj][m][n], 0, 0, 0); __builtin_amdgcn_s_setprio(0); } while (0)
#define PG8_WAIT_V(n) asm volatile("s_waitcnt vmcnt(" #n ")" ::: "memory")
#define PG8_WAIT_L(n) asm volatile("s_waitcnt lgkmcnt(" #n ")" ::: "memory")
#define PG8_BAR __builtin_amdgcn_s_barrier()
#define PG8_SCHED __builtin_amdgcn_sched_barrier(0)
    Unit cur, nxt; int ui = 0;
    if (!S.next(0, cur)) return;
    f32x4 acc[2][2][4][2];
#pragma unroll
    for (int a = 0; a < 2; ++a)
#pragma unroll
        for (int b = 0; b < 2; ++b)
#pragma unroll
            for (int m = 0; m < 4; ++m)
#pragma unroll
                for (int n = 0; n < 2; ++n) acc[a][b][m][n] = (f32x4){0.f, 0.f, 0.f, 0.f};
    bf16x8 At[4][2], B0[2][2], B1[2][2];
    const char* cA = (const char*)g.A + (Sched::GATHER ? (size_t)0 : (size_t)cur.pm * tstep); const char* cB = (const char*)g.Bt + (size_t)cur.pn * tstep;
    S.a_ready(cur);
    if constexpr (Sched::GATHER) { S.rows(cur, 0, tid, K, gA);
#pragma unroll
        for (int h = 0; h < 2; ++h)
#pragma unroll
            for (int i = 0; i < 2; ++i) gAn[h][i] = gA[h][i]; }
    if constexpr (SP2) {
        PG8_STAGE(PG8_SB(0, 0), cB, voffB); PG8_STAGE(PG8_SB(0, 1), cB + hstep, voffB); PG8_STAGE_A(PG8_SA(0, 0), cA, 0, false); PG8_STAGE_A(PG8_SA(0, 1), cA, 1, false);
        if (wr == 1) PG8_BAR;
        PG8_WAIT_V(2); PG8_BAR;
        PG8_STAGE(PG8_SB(1, 0), cB + kstep, voffB); PG8_STAGE_A(PG8_SA(1, 0), cA + kstep, 0, false); PG8_STAGE(PG8_SB(1, 1), cB + hstep + kstep, voffB);
        PG8_WAIT_V(6); PG8_BAR;
    } else {
        PG8_STAGE(PG8_SB(0, 0), cB, voffB); PG8_STAGE_A(PG8_SA(0, 0), cA, 0, false); PG8_STAGE(PG8_SB(0, 1), cB + hstep, voffB); PG8_STAGE_A(PG8_SA(0, 1), cA, 1, false);
        if (wr == 1) PG8_BAR;
        PG8_WAIT_V(4); PG8_BAR;
        PG8_STAGE(PG8_SB(1, 0), cB + kstep, voffB); PG8_STAGE_A(PG8_SA(1, 0), cA + kstep, 0, false); PG8_STAGE(PG8_SB(1, 1), cB + hstep + kstep, voffB);
        PG8_WAIT_V(6); PG8_BAR;
    }
    for (;;) {
        const bool has_next = S.next(ui + 1, nxt);
        const char* nA = (has_next && !Sched::GATHER) ? (const char*)g.A + (size_t)nxt.pm * tstep : cA; const char* nB = has_next ? (const char*)g.Bt + (size_t)nxt.pn * tstep : cB;
        if constexpr (Sched::GATHER) { if (has_next) S.rows(nxt, ui + 1, tid, K, gAn); }
        if constexpr (Epi::LDS_BIAS) E.prefetch(cur, ui & 1, lds, wid, lane);
        for (int t = 0; t < nt; t += 2) {
            const bool last = (t == nt - 2);
            const char* a1 = cA + (size_t)(t + 1) * kstep;
            const char* a2 = last ? nA : cA + (size_t)(t + 2) * kstep; const char* b2 = last ? nB : cB + (size_t)(t + 2) * kstep;
            const char* a3 = a2 + kstep; const char* b3 = b2 + kstep;
            if (last && has_next) S.a_ready(nxt);
            if constexpr (SP2) {
            PG8_LDB(B0, 0, 0); PG8_LDB(B1, 0, 1); PG8_SCHED; PG8_LDA(At, 0, 0); PG8_STAGE_A(PG8_SA(1, 1), a1, 1, false);
            PG8_WAIT_V(8); PG8_WAIT_L(0); PG8_BAR; PG8_MMA(0, 0, At, B0); PG8_MMA(0, 1, At, B1); PG8_BAR; PG8_SCHED;
            PG8_LDA(At, 0, 1); PG8_STAGE(PG8_SB(0, 0), b2, voffB); PG8_STAGE(PG8_SB(0, 1), b2 + hstep, voffB); PG8_STAGE_A(PG8_SA(0, 0), a2, 0, last);
            PG8_WAIT_V(8); PG8_WAIT_L(0); PG8_BAR; PG8_MMA(1, 0, At, B0); PG8_MMA(1, 1, At, B1); PG8_BAR; PG8_SCHED;
            PG8_LDB(B0, 1, 0); PG8_LDB(B1, 1, 1); PG8_SCHED; PG8_LDA(At, 1, 0); PG8_STAGE_A(PG8_SA(0, 1), a2, 1, last);
            PG8_WAIT_V(8); PG8_WAIT_L(0); PG8_BAR; PG8_MMA(0, 0, At, B0); PG8_MMA(0, 1, At, B1); PG8_BAR; PG8_SCHED;
            PG8_LDA(At, 1, 1); PG8_STAGE(PG8_SB(1, 0), b3, voffB); PG8_STAGE(PG8_SB(1, 1), b3 + hstep, voffB); PG8_STAGE_A(PG8_SA(1, 0), a3, 0, last);
            PG8_WAIT_V(8); PG8_WAIT_L(0); PG8_BAR; PG8_MMA(1, 0, At, B0); PG8_MMA(1, 1, At, B1); PG8_BAR; PG8_SCHED;
            } else {
            PG8_LDB(B0, 0, 0); PG8_SCHED; PG8_LDA(At, 0, 0); PG8_STAGE_A(PG8_SA(1, 1), a1, 1, false);
            PG8_WAIT_L(8); PG8_BAR; PG8_WAIT_L(0); PG8_MMA(0, 0, At, B0); PG8_BAR; PG8_SCHED;
            PG8_LDB(B1, 0, 1); PG8_STAGE(PG8_SB(0, 0), b2, voffB);
            PG8_BAR; PG8_WAIT_L(0); PG8_MMA(0, 1, At, B1); PG8_BAR;
            PG8_LDA(At, 0, 1); PG8_STAGE_A(PG8_SA(0, 0), a2, 0, last);
            PG8_BAR; PG8_WAIT_L(0); PG8_MMA(1, 0, At, B0); PG8_BAR; PG8_SCHED;
            PG8_STAGE(PG8_SB(0, 1), b2 + hstep, voffB);
            PG8_WAIT_V(6); PG8_BAR; PG8_MMA(1, 1, At, B1); PG8_BAR;
            PG8_LDB(B0, 1, 0); PG8_SCHED; PG8_LDA(At, 1, 0); PG8_STAGE_A(PG8_SA(0, 1), a2, 1, last);
            PG8_WAIT_L(8); PG8_BAR; PG8_WAIT_L(0); PG8_MMA(0, 0, At, B0); PG8_BAR; PG8_SCHED;
            PG8_LDB(B1, 1, 1); PG8_STAGE(PG8_SB(1, 0), b3, voffB);
            PG8_BAR; PG8_WAIT_L(0); PG8_MMA(0, 1, At, B1); PG8_BAR;
            PG8_LDA(At, 1, 1); PG8_STAGE_A(PG8_SA(1, 0), a3, 0, last);
            PG8_BAR; PG8_WAIT_L(0); PG8_MMA(1, 0, At, B0); PG8_BAR; PG8_SCHED;
            PG8_STAGE(PG8_SB(1, 1), b3 + hstep, voffB);
            PG8_WAIT_V(6); PG8_BAR; PG8_MMA(1, 1, At, B1); PG8_BAR;
            }
        }
        if constexpr (ALIGN_EPI) { if (wr == 0) PG8_BAR; }
        if constexpr (!Epi::AFTER_DRAIN) { if constexpr (Epi::LDS_BIAS) E(acc, cur, wr, wc, fr, fq, lds, ui & 1); else E(acc, cur, wr, wc, fr, fq); S.done(cur); }
        if (!has_next) break;
#pragma unroll
        for (int a = 0; a < 2; ++a)
#pragma unroll
            for (int b = 0; b < 2; ++b)
#pragma unroll
                for (int m = 0; m < 4; ++m)
#pragma unroll
                    for (int n = 0; n < 2; ++n) acc[a][b][m][n] = (f32x4){0.f, 0.f, 0.f, 0.f};
        cur = nxt; cA = nA; cB = nB; ++ui;
        if constexpr (Sched::GATHER) {
#pragma unroll
            for (int h = 0; h < 2; ++h)
#pragma unroll
                for (int i = 0; i < 2; ++i) gA[h][i] = gAn[h][i]; }
        if constexpr (ALIGN_EPI) { if (wr == 1) PG8_BAR; }
    }
    PG8_WAIT_V(0);
    if constexpr (!ALIGN_EPI) { if (wr == 0) PG8_BAR; }
    PG8_BAR;
    if constexpr (Epi::AFTER_DRAIN) { E.fused(acc, cur, wr, wc, fr, fq, lds, wid, lane); S.done(cur); }
#undef PG8_SA
#undef PG8_SB
#undef PG8_STAGE
#undef PG8_STAGE_A
#undef PG8_LDA
#undef PG8_LDB
#undef PG8_MMA
#undef PG8_WAIT_V
#undef PG8_WAIT_L
#undef PG8_BAR
#undef PG8_SCHED
}
}

constexpr int D = 1024, NB = 16, SEQ = 2048, CL = 256, ML = NB * SEQ, MC = NB * CL, MT = ML + MC;
constexpr int NIN = 2992, NINP = 3072, NE = 32, NMODC = 6 * D;
constexpr int PC_AQ = 0, PC_AK = 256, PC_AV = 384, PC_GQ = 512, PC_GZ = 2048, PC_GA = 2560, PC_GB = 2568, PC_CQ = 2576, PC_CKV = 2832, PC_CKR = 2960;
constexpr float EPS = 1e-6f;
constexpr int NSLOT = (MT * 4 / 256 + NE) * 256;
constexpr int NWAVES = 8, NTHR = 512;

constexpr size_t MiB = 1u << 20;
constexpr size_t WS_CTL = 0, CTL_ZERO_BYTES = 1 * MiB;
constexpr size_t WS_MODV = 1 * MiB;
constexpr size_t WS_BGU = 2 * MiB;
constexpr size_t WS_PAIRE = 3 * MiB;
constexpr size_t WS_PAIRR = 4 * MiB;
constexpr size_t WS_PAIRG = 5 * MiB;
constexpr size_t WS_SLOTG = 6 * MiB;
constexpr size_t WS_RWH = 7 * MiB;
constexpr size_t WS_RWL = 7 * MiB + 262144;
constexpr size_t WS_WIN = 8 * MiB;
constexpr size_t WS_WOUT = 20 * MiB;
constexpr size_t WS_WGU = 24 * MiB;
constexpr size_t WS_WDN = 280 * MiB;
constexpr size_t WS_XW = 408 * MiB;
constexpr size_t WS_H = 552 * MiB;
constexpr size_t WS_MIX = 624 * MiB;
constexpr size_t WS_BIG = 696 * MiB;
constexpr size_t WS_P = WS_BIG;
constexpr size_t WS_QA = WS_BIG + 217 * MiB;
constexpr size_t WS_KA = WS_BIG + 253 * MiB;
constexpr size_t WS_VA = WS_BIG + 271 * MiB;
constexpr size_t WS_QM = WS_BIG + 289 * MiB;
constexpr size_t WS_KM = WS_BIG + 343 * MiB;
constexpr size_t WS_VM = WS_BIG + 397 * MiB;
constexpr size_t WS_GW = WS_BIG + 433 * MiB;
constexpr size_t WS_GQD = WS_BIG + 505 * MiB;
constexpr size_t WS_GKDT = WS_BIG + 577 * MiB;
constexpr size_t WS_GQKM = WS_BIG + 649 * MiB;
constexpr size_t WS_GUT = WS_BIG + 685 * MiB;
constexpr size_t WS_GGE = WS_BIG + 829 * MiB;
constexpr size_t WS_OD = WS_BIG + 830 * MiB;
constexpr size_t WS_XS = WS_BIG;
constexpr size_t WS_ACT = WS_BIG + 304 * MiB;
constexpr size_t WS_Y = WS_BIG + 608 * MiB;
constexpr size_t WS_PAIRS = WS_BIG + 974 * MiB;
constexpr size_t WS_TOK = WS_BIG + 975 * MiB;
constexpr size_t WS_TOKE = WS_BIG + 976 * MiB;
constexpr size_t WS_GATEE = WS_BIG + 981 * MiB;
constexpr size_t WS_WUQF = WS_BIG + 986 * MiB;
constexpr size_t WS_WUKVF = WS_BIG + 987 * MiB;
constexpr size_t WS_END = WS_BIG + 988 * MiB;
static_assert((size_t)NSLOT * 2048 <= 304 * MiB && (size_t)MT * 3072 * 2 + 8192 <= 217 * MiB, "ws map");
constexpr int CW_BAR = 4096;
constexpr int CW_CNT = 16384;
constexpr int CW_AQ = 12288;

constexpr int RING_BYTES = 131072, TAB_OFF = RING_BYTES, LDS_BYTES = 155648;
constexpr int MISC_OFF = LDS_BYTES - 256;

#define LAS __attribute__((address_space(3)))
typedef unsigned short bf16;
typedef unsigned v4u __attribute__((ext_vector_type(4)));
typedef unsigned v2u __attribute__((ext_vector_type(2)));
typedef float f32x4 __attribute__((ext_vector_type(4)));
typedef short bf16x8_t __attribute__((ext_vector_type(8)));
#define LDS_WAIT() asm volatile("s_waitcnt lgkmcnt(0)" ::: "memory")
__device__ __forceinline__ unsigned f2bf(float f) { unsigned u = __builtin_bit_cast(unsigned, f); return (u + 0x7fffu + ((u >> 16) & 1u)) >> 16; }
typedef float f32x2_t __attribute__((ext_vector_type(2)));
typedef __bf16 bf16x2_t __attribute__((ext_vector_type(2)));
__device__ __forceinline__ unsigned pk2(float lo, float hi) { const f32x2_t v = {lo, hi}; const bf16x2_t b = __builtin_convertvector(v, bf16x2_t); return __builtin_bit_cast(unsigned, b); }
__device__ __forceinline__ float bf2f(unsigned short b) { return __builtin_bit_cast(float, ((unsigned)b) << 16); }
__device__ __forceinline__ float bflo(unsigned w) { return __builtin_bit_cast(float, w << 16); }
__device__ __forceinline__ float bfhi(unsigned w) { return __builtin_bit_cast(float, w & 0xffff0000u); }
__device__ __forceinline__ float wave_sum(float v) {
#pragma unroll
    for (int o = 1; o < 64; o <<= 1) v += __shfl_xor(v, o);
    return v;
}
__device__ __forceinline__ float siluf(float x) { return x * __builtin_amdgcn_rcpf(1.f + __expf(-x)); }

#define XB_TMO      128
#define XB_XCNT(j)  (256  + 64 * (j))
#define XB_XSUB(j)  (1280 + 64 * (j))
#define XB_XGEN(j)  (2304 + 64 * (j))
#define XB_TOP      3328
#define XB_TOPGEN   3392
#define XCD_BAR_WORDS 3456
#define XB_SPIN_CAP (1u << 18)
__device__ __forceinline__ unsigned xb_ld(unsigned* p)              { return __hip_atomic_load(p, __ATOMIC_RELAXED, __HIP_MEMORY_SCOPE_AGENT); }
__device__ __forceinline__ unsigned xb_add(unsigned* p, unsigned v) { return __hip_atomic_fetch_add(p, v, __ATOMIC_RELAXED, __HIP_MEMORY_SCOPE_AGENT); }
__device__ __forceinline__ unsigned xb_xcc_id() { return (unsigned)__builtin_amdgcn_s_getreg((3 << 11) | 20) & 0xFu; }
#define XB_SPIN(cond, bar) do { unsigned _sp = 0; while (cond) { __builtin_amdgcn_s_sleep(1); \
    if ((++_sp & 255u) == 0u) { if (xb_ld(&(bar)[XB_TMO])) break; if (_sp > XB_SPIN_CAP) { atomicAdd(&(bar)[XB_TMO], 1u); break; } } } } while (0)
struct XcdBarrier { unsigned* bar; unsigned x; volatile LAS unsigned* st; };
__device__ __forceinline__ XcdBarrier xcd_barrier_post(unsigned* bar, volatile LAS unsigned* st) {
    XcdBarrier b; b.bar = bar; b.x = xb_xcc_id(); b.st = st;
    if (threadIdx.x == 0) (void)xb_add(&bar[XB_XCNT(b.x)], 1u);
    return b;
}
__device__ __forceinline__ void xcd_barrier_complete(unsigned* bar, unsigned x, unsigned& nloc, unsigned& nx) {
    const unsigned G = gridDim.x * gridDim.y * gridDim.z;
    unsigned sum, cnt, mine, sp = 0u;
    for (;;) {
        sum = 0u; cnt = 0u; mine = 0u;
#pragma unroll
        for (unsigned j = 0; j < 16; ++j) { const unsigned c = xb_ld(&bar[XB_XCNT(j)]); sum += c; cnt += (c > 0u) ? 1u : 0u; mine = (j == x) ? c : mine; }
        if (sum == G) break;
        __builtin_amdgcn_s_sleep(1);
        if ((++sp & 255u) == 0u) { if (xb_ld(&bar[XB_TMO])) break; if (sp > XB_SPIN_CAP) { atomicAdd(&bar[XB_TMO], 1u); break; } }
    }
    nloc = mine > 0u ? mine : 1u; nx = cnt > 0u ? cnt : 1u;
}
__device__ __forceinline__ void xcd_barrier(const XcdBarrier& b) {
    asm volatile("s_waitcnt vmcnt(0)" ::: "memory");
    __syncthreads();
    if (threadIdx.x == 0) {
        unsigned* bar = b.bar;
        __builtin_amdgcn_s_waitcnt(0);
        unsigned nloc = b.st[0], nx = b.st[1];
        if (nloc == 0u) { xcd_barrier_complete(bar, b.x, nloc, nx); b.st[0] = nloc; b.st[1] = nx; }
        const unsigned old = xb_add(&bar[XB_XSUB(b.x)], 1u);
        const unsigned gen = old / nloc;
        if (old + 1u == (gen + 1u) * nloc) {
            __builtin_amdgcn_fence(__ATOMIC_RELEASE, "agent");
            asm volatile("s_waitcnt vmcnt(0)" ::: "memory");
            const unsigned og = xb_add(&bar[XB_TOP], 1u);
            const unsigned tg = og / nx;
            if (og + 1u == (tg + 1u) * nx) xb_add(&bar[XB_TOPGEN], 1u);
            else XB_SPIN(xb_ld(&bar[XB_TOPGEN]) == tg, bar);
            __builtin_amdgcn_fence(__ATOMIC_ACQUIRE, "agent");
            xb_add(&bar[XB_XGEN(b.x)], 1u);
            asm volatile("s_waitcnt vmcnt(0)" ::: "memory");
        } else {
            XB_SPIN(xb_ld(&bar[XB_XGEN(b.x)]) == gen, bar);
            __builtin_amdgcn_fence(__ATOMIC_ACQUIRE, "agent");
            asm volatile("s_waitcnt vmcnt(0)" ::: "memory");
        }
    }
    __syncthreads();
}

namespace pg8 {
struct EpiStoreBf16 {
    static constexpr bool PERM = true, AFTER_DRAIN = false, LDS_BIAS = false;
    bf16_t* O; int ldc;
    __device__ __forceinline__ void operator()(const f32x4 (&acc)[2][2][4][2], const Unit& u, int wr, int wc, int fr, int fq) const {
        const int row0 = u.pm * BM + wr * 64 + fr, col0 = u.pn * BM + wc * 32 + 8 * fq;
#pragma unroll
        for (int ai = 0; ai < 2; ++ai)
#pragma unroll
            for (int m = 0; m < 4; ++m) { bf16_t* rowp = O + (size_t)(row0 + ai * HALF + m * 16) * ldc + col0;
#pragma unroll
                for (int bj = 0; bj < 2; ++bj) { const f32x4 v0 = acc[ai][bj][m][0], v1 = acc[ai][bj][m][1];
                    u32x4 w; w.x = cvt_pk_bf16(v0[0], v0[1]); w.y = cvt_pk_bf16(v0[2], v0[3]); w.z = cvt_pk_bf16(v1[0], v1[1]); w.w = cvt_pk_bf16(v1[2], v1[3]);
                    *(u32x4*)(rowp + bj * HALF) = w; } }
    }
};
struct EpiResid {
    static constexpr bool PERM = false, AFTER_DRAIN = false, LDS_BIAS = false;
    const float* xlat; const float* xctx; const bf16_t* xb; bf16_t* out; const float* modv;
    __device__ __forceinline__ void operator()(const f32x4 (&acc)[2][2][4][2], const Unit& u, int wr, int wc, int fr, int fq) const {
        const int row0 = u.pm * BM + wr * 64 + fr, col0 = u.pn * BM + wc * 32 + 4 * fq;
        const int b = (u.pm < ML / BM) ? (u.pm / (SEQ / BM)) : NB;
        const float* g = modv + (size_t)b * NMODC + 2 * D + col0;
        const float* xin = (u.pm < ML / BM) ? xlat : (xctx - (size_t)ML * D);
        f32x4 gv[2][2];
#pragma unroll
        for (int bj = 0; bj < 2; ++bj)
#pragma unroll
            for (int n = 0; n < 2; ++n) gv[bj][n] = *(const f32x4*)(g + bj * HALF + n * 16);
        typedef unsigned u32x2_ __attribute__((ext_vector_type(2)));
        if (xb) {
#pragma unroll
            for (int ai = 0; ai < 2; ++ai)
#pragma unroll
                for (int m = 0; m < 4; ++m) { const size_t off = (size_t)(row0 + ai * HALF + m * 16) * D + col0;
                    u32x2_ rw[2][2];
#pragma unroll
                    for (int bj = 0; bj < 2; ++bj)
#pragma unroll
                        for (int n = 0; n < 2; ++n) rw[bj][n] = *(const u32x2_*)(xb + off + bj * HALF + n * 16);
#pragma unroll
                    for (int bj = 0; bj < 2; ++bj)
#pragma unroll
                        for (int n = 0; n < 2; ++n) { const unsigned w0 = rw[bj][n].x, w1 = rw[bj][n].y;
                            const f32x4 xi = (f32x4){__builtin_bit_cast(float, w0 << 16), __builtin_bit_cast(float, w0 & 0xffff0000u), __builtin_bit_cast(float, w1 << 16), __builtin_bit_cast(float, w1 & 0xffff0000u)};
                            const f32x4 v = xi + gv[bj][n] * acc[ai][bj][m][n];
                            u32x2_ ow; ow.x = cvt_pk_bf16(v[0], v[1]); ow.y = cvt_pk_bf16(v[2], v[3]);
                            *(u32x2_*)(out + off + bj * HALF + n * 16) = ow; } }
        } else {
#pragma unroll
            for (int ai = 0; ai < 2; ++ai)
#pragma unroll
                for (int m = 0; m < 4; ++m) { const size_t off = (size_t)(row0 + ai * HALF + m * 16) * D + col0;
#pragma unroll
                    for (int bj = 0; bj < 2; ++bj)
#pragma unroll
                        for (int n = 0; n < 2; ++n) { const f32x4 xi = *(const f32x4*)(xin + off + bj * HALF + n * 16);
                            const f32x4 v = xi + gv[bj][n] * acc[ai][bj][m][n];
                            u32x2_ ow; ow.x = cvt_pk_bf16(v[0], v[1]); ow.y = cvt_pk_bf16(v[2], v[3]);
                            *(u32x2_*)(out + off + bj * HALF + n * 16) = ow; } }
        }
    }
};
template <bool GATHER_> struct MoeOrderT {
    static constexpr bool GATHER = GATHER_;
    const LAS int* tstart; int TR, nsub, G, c; const int* tok;
    __device__ __forceinline__ bool next(int i, Unit& u) const {
        int rt, pl;
        if ((G & 7) == 0) { const int x = c & 7, j = c >> 3, bpx = G >> 3; const int r0 = (TR * x) >> 3, r1 = (TR * (x + 1)) >> 3; const int m = i * bpx + j;
            rt = r0 + m / nsub; pl = m % nsub; if (rt >= r1) return false; }
        else { const long L = (long)i * G + c; rt = (int)(L / nsub); pl = (int)(L % nsub); if (rt >= TR) return false; }
        int e = 0, hi = NE;
#pragma unroll
        for (int st = 0; st < 5; ++st) { const int mid = (e + hi) >> 1; const bool le = __builtin_amdgcn_readfirstlane(tstart[mid]) <= rt; e = le ? mid : e; hi = le ? hi : mid; }
        e = __builtin_amdgcn_readfirstlane(e);
        u.pm = rt; u.pn = e * nsub + pl; return true;
    }
    static constexpr int MAXU = 22;
    const LAS unsigned short* ltab;
    __device__ __forceinline__ void preload(LAS unsigned short* tab, int tid) const {
        Unit u;
        for (int ord = 0; ord < MAXU && next(ord, u); ++ord) if (tid < BM) { const int e = u.pn / nsub, rank = (u.pm - tstart[e]) * BM + tid;
            tab[ord * BM + tid] = (rank < tstart[33 + e]) ? (unsigned short)tok[(size_t)e * MT + rank] : (unsigned short)0; }
    }
    __device__ __forceinline__ void rows(const Unit& u, int ord, int tid, int K, unsigned (&out)[2][2]) const {
#pragma unroll
        for (int i = 0; i < 2; ++i) { int R, C; stage_rc(tid * 16 + i * 8192, R, C);
#pragma unroll
            for (int h = 0; h < 2; ++h) out[h][i] = (unsigned)ltab[ord * BM + h * HALF + R] * (unsigned)(K * 2) + (unsigned)C * 2u; }
    }
    __device__ __forceinline__ void a_ready(const Unit&) const {}
    __device__ __forceinline__ void done(const Unit&) const {}
};
constexpr int EBUF_OFF = TAB_OFF + 512 + 22 * 512;
struct EpiSwiglu {
    static constexpr bool PERM = true, AFTER_DRAIN = false, LDS_BIAS = true;
    bf16_t* O; const float* bias;
    __device__ __forceinline__ void prefetch(const Unit& u, int par, PG8_LAS unsigned char* lds, int wid, int lane) const {
        if (wid == 0) __builtin_amdgcn_global_load_lds((const unsigned*)(bias + (size_t)(u.pn >> 3) * 2048 + (u.pn & 7) * 256 + lane * 4), (PG8_LAS unsigned*)(lds + EBUF_OFF + par * 2048), 16, 0, 0);
    }
    __device__ __forceinline__ void operator()(const f32x4 (&acc)[2][2][4][2], const Unit& u, int wr, int wc, int fr, int fq, PG8_LAS unsigned char* lds, int par) const {
        const int pl = u.pn & 7;
        const int row0 = u.pm * BM + wr * 64 + fr, c0 = wc * 32 + 8 * fq;
        const PG8_LAS float* bp = (const PG8_LAS float*)(lds + EBUF_OFF + par * 2048) + c0;
        f32x4 bg[2], bl[2];
#pragma unroll
        for (int n = 0; n < 2; ++n) { bg[n] = *(const PG8_LAS f32x4*)(bp + 4 * n); bl[n] = *(const PG8_LAS f32x4*)(bp + HALF + 4 * n); }
#pragma unroll
        for (int ai = 0; ai < 2; ++ai)
#pragma unroll
            for (int m = 0; m < 4; ++m) { bf16_t* rowp = O + (size_t)(row0 + ai * HALF + m * 16) * 1024 + pl * 128 + c0;
                float r[8];
#pragma unroll
                for (int n = 0; n < 2; ++n)
#pragma unroll
                    for (int j = 0; j < 4; ++j) { const float gl = fminf(acc[ai][0][m][n][j] + bg[n][j], 7.0f);
                        const float li = fminf(fmaxf(acc[ai][1][m][n][j] + bl[n][j], -7.0f), 7.0f);
                        r[n * 4 + j] = gl * __builtin_amdgcn_rcpf(1.f + __expf(-1.702f * gl)) * (li + 1.f); }
                u32x4 w; w.x = cvt_pk_bf16(r[0], r[1]); w.y = cvt_pk_bf16(r[2], r[3]); w.z = cvt_pk_bf16(r[4], r[5]); w.w = cvt_pk_bf16(r[6], r[7]);
                *(u32x4*)rowp = w; }
    }
};
struct EpiDown {
    static constexpr bool PERM = true, AFTER_DRAIN = false, LDS_BIAS = true;
    bf16_t* O; const float* bias; const float* slotg; const PG8_LAS int* tstart;
    __device__ __forceinline__ void prefetch(const Unit& u, int par, PG8_LAS unsigned char* lds, int wid, int lane) const {
        if (wid == 0) __builtin_amdgcn_global_load_lds((const unsigned*)(bias + (size_t)(u.pn >> 2) * 1024 + (u.pn & 3) * 256 + lane * 4), (PG8_LAS unsigned*)(lds + EBUF_OFF + par * 2048), 16, 0, 0);
        if (wid == 1) { const int e = u.pn >> 2; __builtin_amdgcn_global_load_lds((const unsigned*)(slotg + (size_t)e * MT + (size_t)(u.pm - tstart[e]) * BM + lane * 4), (PG8_LAS unsigned*)(lds + EBUF_OFF + par * 2048 + 1024), 16, 0, 0); }
    }
    __device__ __forceinline__ void operator()(const f32x4 (&acc)[2][2][4][2], const Unit& u, int wr, int wc, int fr, int fq, PG8_LAS unsigned char* lds, int par) const {
        const int pl = u.pn & 3;
        const int rl0 = wr * 64 + fr, cl0 = wc * 32 + 8 * fq; const int row0 = u.pm * BM + rl0, col0 = pl * BM + cl0;
        const PG8_LAS float* eb = (const PG8_LAS float*)(lds + EBUF_OFF + par * 2048);
        f32x4 bv[2][2];
#pragma unroll
        for (int bj = 0; bj < 2; ++bj)
#pragma unroll
            for (int n = 0; n < 2; ++n) bv[bj][n] = *(const PG8_LAS f32x4*)(eb + cl0 + bj * HALF + 4 * n);
#pragma unroll
        for (int ai = 0; ai < 2; ++ai)
#pragma unroll
            for (int m = 0; m < 4; ++m) { const int row = row0 + ai * HALF + m * 16; const float gt = eb[256 + rl0 + ai * HALF + m * 16]; bf16_t* rowp = O + (size_t)row * 1024 + col0;
#pragma unroll
                for (int bj = 0; bj < 2; ++bj) { const f32x4 v0 = (acc[ai][bj][m][0] + bv[bj][0]) * gt, v1 = (acc[ai][bj][m][1] + bv[bj][1]) * gt;
                    u32x4 w; w.x = cvt_pk_bf16(v0[0], v0[1]); w.y = cvt_pk_bf16(v0[2], v0[3]); w.z = cvt_pk_bf16(v1[0], v1[1]); w.w = cvt_pk_bf16(v1[2], v1[3]);
                    *(u32x4*)(rowp + bj * HALF) = w; } }
    }
};
}

template <int DQK>
__device__ __forceinline__ void attn_block(LAS unsigned char* lds, const bf16* Qb, int qpitch, const bf16* K, const bf16* Vt, int tA0, int tA1, int tB0, int tB1,
                                           int q0, bool masked, float sc_l2, bool has_sink, float sink_l2, bf16* Ob, int tid) {
    constexpr int NKS = DQK / 32, CPR = DQK / 8  , KP = DQK * 2 + 32  , VP = 160  , KBYTES = 64 * KP, STAGE = KBYTES + 64 * VP;
    const int lane = tid & 63, wv = __builtin_amdgcn_readfirstlane(tid >> 6), r = lane & 15, g = lane >> 4;
    const bf16* Q = Qb + (size_t)(32 * wv) * qpitch; bf16* O = Ob + (size_t)(32 * wv) * D; const int t0 = q0 + 32 * wv;
    bf16x8_t qf[2][NKS];
#pragma unroll
    for (int qb = 0; qb < 2; ++qb)
#pragma unroll
        for (int ks = 0; ks < NKS; ++ks) qf[qb][ks] = *(const bf16x8_t*)(Q + (size_t)(16 * qb + r) * qpitch + 32 * ks + 8 * g);
    f32x4 oacc[2][4];
#pragma unroll
    for (int qb = 0; qb < 2; ++qb)
#pragma unroll
        for (int nb = 0; nb < 4; ++nb) oacc[qb][nb] = (f32x4){0.f, 0.f, 0.f, 0.f};
    float mrun[2] = {-INFINITY, -INFINITY}, lrun[2] = {0.f, 0.f};
    const int kr0 = tid / CPR, kc0 = tid % CPR, kr1 = (tid + 512) / CPR, kc1 = (tid + 512) % CPR, vr = tid >> 3, vc = tid & 7;
    const bool two = (CPR * 64 > 512) && (tid + 512 < CPR * 64);
    v4u sk0, sk1 = (v4u){0u, 0u, 0u, 0u}, sv;
    const unsigned ko0 = (unsigned)(kr0 * DQK + kc0 * 8) * 2u, ko1 = (unsigned)(kr1 * DQK + kc1 * 8) * 2u, vo = (unsigned)(vr * 2304 + vc * 8) * 2u;
#define AB_GLOAD(kt_) do { const char* kb_ = (const char*)K + (size_t)((kt_) * 64) * (DQK * 2); const char* vb_ = (const char*)Vt + (size_t)((kt_) * 64) * 2; \
        sk0 = *(const v4u*)(kb_ + ko0); if (two) sk1 = *(const v4u*)(kb_ + ko1); sv = *(const v4u*)(vb_ + vo); } while (0)
#define AB_LSTORE(buf_) do { LAS unsigned char* sb_ = lds + (buf_) * STAGE; *(LAS v4u*)(sb_ + kr0 * KP + kc0 * 16) = sk0; if (two) *(LAS v4u*)(sb_ + kr1 * KP + kc1 * 16) = sk1; \
        *(LAS v4u*)(sb_ + KBYTES + vr * VP + vc * 16) = sv; } while (0)
    int kt = tA0, buf = 0;
    if (kt >= tA1) kt = tB0;
    if (kt < tB1) { AB_GLOAD(kt); AB_LSTORE(0); }
    __syncthreads();
    if (wv >= 4) __builtin_amdgcn_s_setprio(1);
    while (kt < tB1) {
        const int ktn = (kt + 1 == tA1) ? tB0 : kt + 1;
        if (ktn < tB1) AB_GLOAD(ktn);
        const int key0 = kt * 64;
        const bool live = !masked || key0 < CL || !((key0 - CL) + 63 < t0 - 128 || (key0 - CL) > t0 + 31 + 128);
        if (live) {
            const LAS unsigned char* sb = lds + buf * STAGE;
            bf16x8_t kf[4][NKS], vf[2][4];
#pragma unroll
            for (int blk = 0; blk < 4; ++blk)
#pragma unroll
                for (int ks = 0; ks < NKS; ++ks) kf[blk][ks] = *(const LAS bf16x8_t*)(sb + (16 * blk + r) * KP + 64 * ks + 16 * g);
#pragma unroll
            for (int sub = 0; sub < 2; ++sub)
#pragma unroll
                for (int nb = 0; nb < 4; ++nb) vf[sub][nb] = *(const LAS bf16x8_t*)(sb + KBYTES + (16 * nb + r) * VP + 64 * sub + 16 * g);
#pragma unroll
            for (int qb = 0; qb < 2; ++qb) {
                f32x4 s[4];
#pragma unroll
                for (int blk = 0; blk < 4; ++blk) { s[blk] = (f32x4){0.f, 0.f, 0.f, 0.f};
#pragma unroll
                    for (int ks = 0; ks < NKS; ++ks) s[blk] = __builtin_amdgcn_mfma_f32_16x16x32_bf16(kf[blk][ks], qf[qb][ks], s[blk], 0, 0, 0); }
                float tmax = -INFINITY;
#pragma unroll
                for (int blk = 0; blk < 4; ++blk)
#pragma unroll
                    for (int i = 0; i < 4; ++i) { float x = s[blk][i] * sc_l2;
                        if (masked) { const int kk = key0 + 16 * blk + 4 * g + i; const int dj = (t0 + 16 * qb + r) - (kk - CL); if (kk >= CL && (dj > 128 || dj < -128)) x = -INFINITY; }
                        s[blk][i] = x; tmax = fmaxf(tmax, x); }
                tmax = fmaxf(tmax, __shfl_xor(tmax, 16)); tmax = fmaxf(tmax, __shfl_xor(tmax, 32));
                const bool rebase = __any(tmax > mrun[qb] + 8.0f);
                const float mn = rebase ? fmaxf(mrun[qb], tmax) : mrun[qb];
                float p[16], ps = 0.f;
#pragma unroll
                for (int blk = 0; blk < 4; ++blk)
#pragma unroll
                    for (int i = 0; i < 4; ++i) { p[blk * 4 + i] = __builtin_amdgcn_exp2f(s[blk][i] - mn); ps += p[blk * 4 + i]; }
                if (rebase) { const float corr = __builtin_amdgcn_exp2f(mrun[qb] - mn); lrun[qb] *= corr;
#pragma unroll
                    for (int nb = 0; nb < 4; ++nb) oacc[qb][nb] = oacc[qb][nb] * corr; }
                lrun[qb] += ps; mrun[qb] = mn;
                bf16x8_t pb[2];
#pragma unroll
                for (int sub = 0; sub < 2; ++sub) { v4u pw; pw.x = pk2(p[8 * sub], p[8 * sub + 1]); pw.y = pk2(p[8 * sub + 2], p[8 * sub + 3]); pw.z = pk2(p[8 * sub + 4], p[8 * sub + 5]); pw.w = pk2(p[8 * sub + 6], p[8 * sub + 7]);
                    pb[sub] = __builtin_bit_cast(bf16x8_t, pw); }
#pragma unroll
                for (int nb = 0; nb < 4; ++nb) {
                    oacc[qb][nb] = __builtin_amdgcn_mfma_f32_16x16x32_bf16(vf[0][nb], pb[0], oacc[qb][nb], 0, 0, 0);
                    oacc[qb][nb] = __builtin_amdgcn_mfma_f32_16x16x32_bf16(vf[1][nb], pb[1], oacc[qb][nb], 0, 0, 0); }
            }
        }
        if (ktn < tB1) AB_LSTORE(buf ^ 1);
        __syncthreads();
        kt = ktn; buf ^= 1;
    }
    __builtin_amdgcn_s_setprio(0);
#undef AB_GLOAD
#undef AB_LSTORE
#pragma unroll
    for (int qb = 0; qb < 2; ++qb) {
        float l = lrun[qb]; l += __shfl_xor(l, 16); l += __shfl_xor(l, 32);
        float fin = 1.f;
        if (has_sink) { const float mn = fmaxf(mrun[qb], sink_l2); const float corr = __builtin_amdgcn_exp2f(mrun[qb] - mn); l = l * corr + __builtin_amdgcn_exp2f(sink_l2 - mn); fin = corr; }
        const float inv = fin / l;
#pragma unroll
        for (int nb = 0; nb < 4; ++nb) { const f32x4 o = oacc[qb][nb] * inv; v2u w; w.x = pk2(o.x, o.y); w.y = pk2(o.z, o.w);
            *(v2u*)(O + (size_t)(16 * qb + r) * D + 16 * nb + 4 * g) = w; }
    }
}

struct Args { const float* in[29]; float* out; unsigned char* ws; int ph_lo, ph_hi, rep_mask, pad; };
enum { I_X = 0, I_C, I_CTX, I_CCTX, I_WMOD, I_BMOD, I_NORM1, I_NORM2, I_WIN, I_WOUT, I_SWAQN, I_SWAKN, I_SINK, I_CONV, I_ALOG, I_DTB, I_GONORM,
       I_QANORM, I_WUQ, I_KVANORM, I_WUKV, I_MQN, I_MKN, I_RW, I_RB, I_WGU, I_BGU, I_WDN, I_BDN };

template <int MODE> __device__ __forceinline__ void tr_item(const float* W, int K, int N, bf16* WT, LAS float* scr, int item, int nblk, int lane) {
    const int kb = item / nblk, nb = item % nblk, k0 = 64 * kb, n0 = 32 * nb;
    const int nsrc = n0 + (lane & 31);
    float wv[32];
#pragma unroll
    for (int i = 0; i < 32; ++i) { const int kk = 2 * i + (lane >> 5); wv[i] = (nsrc < N) ? W[(size_t)(k0 + kk) * N + nsrc] : 0.f; }
#pragma unroll
    for (int i = 0; i < 32; ++i) { const int kk = 2 * i + (lane >> 5); scr[kk * 33 + (lane & 31)] = wv[i]; }
    LDS_WAIT(); asm volatile("" ::: "memory");
    const int c = lane & 7;
#pragma unroll
    for (int j = 0; j < 4; ++j) { const int n = (lane >> 3) + 8 * j; const LAS float* s = scr + (8 * c) * 33 + n;
        v4u o; o.x = pk2(s[0 * 33], s[1 * 33]); o.y = pk2(s[2 * 33], s[3 * 33]); o.z = pk2(s[4 * 33], s[5 * 33]); o.w = pk2(s[6 * 33], s[7 * 33]);
        const int col = n0 + n; const int drow = (MODE == 1) ? (((col >> 1) >> 7) * 256 + (col & 1) * 128 + ((col >> 1) & 127)) : col;
        *(v4u*)(WT + (size_t)drow * K + k0 + 8 * c) = o; }
    LDS_WAIT(); asm volatile("" ::: "memory");
}

__device__ __forceinline__ void norm_mod_row(const f32x4 (&v)[4], const float* gain, const float* shift, const float* scale, bf16* orow, int lane) {
    float ss = 0.f;
#pragma unroll
    for (int j = 0; j < 4; ++j) ss += (v[j].x * v[j].x + v[j].y * v[j].y) + (v[j].z * v[j].z + v[j].w * v[j].w);
    const float rstd = rsqrtf(wave_sum(ss) * (1.f / D) + EPS);
#pragma unroll
    for (int j = 0; j < 4; ++j) { const int idx = j * 256 + lane * 4;
        const f32x4 g = *(const f32x4*)(gain + idx), sh = *(const f32x4*)(shift + idx), sc = *(const f32x4*)(scale + idx);
        const f32x4 y = v[j] * rstd * g * (sc + 1.f) + sh;
        v2u o; o.x = pk2(y.x, y.y); o.y = pk2(y.z, y.w); *(v2u*)(orow + idx) = o; }
}

template <int DQK>
__device__ __forceinline__ void attn_unit_mfma(const bf16* Q, int qpitch, const bf16* K, const bf16* Vt, int kta0, int kta1, int ktb0, int ktb1,
                                               int t0, bool masked, float sc_l2, bool has_sink, float sink_l2, bf16* O, int lane) {
    constexpr int NKS = DQK / 32;
    const int r = lane & 15, g = lane >> 4;
    bf16x8_t qf[2][NKS];
#pragma unroll
    for (int qb = 0; qb < 2; ++qb)
#pragma unroll
        for (int ks = 0; ks < NKS; ++ks) qf[qb][ks] = *(const bf16x8_t*)(Q + (size_t)(16 * qb + r) * qpitch + 32 * ks + 8 * g);
    f32x4 oacc[2][4];
#pragma unroll
    for (int qb = 0; qb < 2; ++qb)
#pragma unroll
        for (int nb = 0; nb < 4; ++nb) oacc[qb][nb] = (f32x4){0.f, 0.f, 0.f, 0.f};
    float mrun[2] = {-INFINITY, -INFINITY}, lrun[2] = {0.f, 0.f};
    bf16x8_t nkf[2][NKS], nvf[4];
#define ATT_LOAD(kt_) do { const int key0_ = (kt_) * 32; \
        _Pragma("unroll") for (int blk = 0; blk < 2; ++blk) _Pragma("unroll") for (int ks = 0; ks < NKS; ++ks) nkf[blk][ks] = *(const bf16x8_t*)(K + (size_t)(key0_ + 16 * blk + r) * DQK + 32 * ks + 8 * g); \
        _Pragma("unroll") for (int nb = 0; nb < 4; ++nb) nvf[nb] = *(const bf16x8_t*)(Vt + (size_t)(16 * nb + r) * 2304 + key0_ + 8 * g); } while (0)
    if (kta0 < ktb1) ATT_LOAD(kta0);
    for (int kt = kta0; kt < ktb1;) {
        const int ktn = (kt + 1 == kta1) ? ktb0 : kt + 1;
        const int key0 = kt * 32;
        bf16x8_t kf[2][NKS], vf[4];
#pragma unroll
        for (int blk = 0; blk < 2; ++blk)
#pragma unroll
            for (int ks = 0; ks < NKS; ++ks) kf[blk][ks] = nkf[blk][ks];
#pragma unroll
        for (int nb = 0; nb < 4; ++nb) vf[nb] = nvf[nb];
        if (ktn < ktb1) ATT_LOAD(ktn);
#pragma unroll
        for (int qb = 0; qb < 2; ++qb) {
            f32x4 s[2];
#pragma unroll
            for (int blk = 0; blk < 2; ++blk) { s[blk] = (f32x4){0.f, 0.f, 0.f, 0.f};
#pragma unroll
                for (int ks = 0; ks < NKS; ++ks) s[blk] = __builtin_amdgcn_mfma_f32_16x16x32_bf16(kf[blk][ks], qf[qb][ks], s[blk], 0, 0, 0); }
            float tmax = -INFINITY;
#pragma unroll
            for (int blk = 0; blk < 2; ++blk)
#pragma unroll
                for (int i = 0; i < 4; ++i) { float x = s[blk][i] * sc_l2;
                    if (masked) { const int kk = key0 + 16 * blk + 4 * g + i; const int dj = (t0 + 16 * qb + r) - (kk - CL); if (kk >= CL && (dj > 128 || dj < -128)) x = -INFINITY; }
                    s[blk][i] = x; tmax = fmaxf(tmax, x); }
            tmax = fmaxf(tmax, __shfl_xor(tmax, 16)); tmax = fmaxf(tmax, __shfl_xor(tmax, 32));
            const float mn = fmaxf(mrun[qb], tmax);
            const float corr = __builtin_amdgcn_exp2f(mrun[qb] - mn);
            float p[8], ps = 0.f;
#pragma unroll
            for (int blk = 0; blk < 2; ++blk)
#pragma unroll
                for (int i = 0; i < 4; ++i) { p[blk * 4 + i] = __builtin_amdgcn_exp2f(s[blk][i] - mn); ps += p[blk * 4 + i]; }
            lrun[qb] = lrun[qb] * corr + ps; mrun[qb] = mn;
            v4u pw; pw.x = pk2(p[0], p[1]); pw.y = pk2(p[2], p[3]); pw.z = pk2(p[4], p[5]); pw.w = pk2(p[6], p[7]);
            const bf16x8_t pb = __builtin_bit_cast(bf16x8_t, pw);
#pragma unroll
            for (int nb = 0; nb < 4; ++nb) { oacc[qb][nb] = oacc[qb][nb] * corr; oacc[qb][nb] = __builtin_amdgcn_mfma_f32_16x16x32_bf16(vf[nb], pb, oacc[qb][nb], 0, 0, 0); }
        }
        kt = ktn;
    }
#undef ATT_LOAD
#pragma unroll
    for (int qb = 0; qb < 2; ++qb) {
        float l = lrun[qb]; l += __shfl_xor(l, 16); l += __shfl_xor(l, 32);
        float fin = 1.f;
        if (has_sink) { const float mn = fmaxf(mrun[qb], sink_l2); const float corr = __builtin_amdgcn_exp2f(mrun[qb] - mn); l = l * corr + __builtin_amdgcn_exp2f(sink_l2 - mn); fin = corr; }
        const float inv = fin / l;
#pragma unroll
        for (int nb = 0; nb < 4; ++nb) { const f32x4 o = oacc[qb][nb] * inv; v2u w; w.x = pk2(o.x, o.y); w.y = pk2(o.z, o.w);
            *(v2u*)(O + (size_t)(16 * qb + r) * D + 16 * nb + 4 * g) = w; }
    }
}

constexpr int KT = CL + SEQ;
#define OPAQ(p) asm volatile("" : "+s"(p))
#ifndef PROBE_REP
#define PROBE_REP 0
#endif
#define REPEAT(cls) for (int rep_ = 0, nrep_ = 1 + ((rep_mask >> (cls)) & 1); rep_ < nrep_; ++rep_)
#define WSP(T, name, off) T* name = (T*)(wsb + (off))
#define CAS __attribute__((address_space(4)))
typedef const float* cfp_t;
#define PHASE_VIEW() const CAS unsigned char* kap = (const CAS unsigned char*)__builtin_amdgcn_kernarg_segment_ptr(); OPAQ(kap); \
    const CAS cfp_t* inp = (const CAS cfp_t*)kap; unsigned char* wsb = *(unsigned char* const CAS*)(kap + offsetof(Args, ws)); (void)inp; (void)wsb; \
    unsigned ones_ = ~0u; OPAQ(ones_); int tid = wave0 * 64 + (int)__builtin_amdgcn_mbcnt_hi(ones_, __builtin_amdgcn_mbcnt_lo(ones_, 0u)); asm volatile("" : "+v"(tid)); int bid = bid0; OPAQ(bid); int G = G0; OPAQ(G); \
    const int lane = tid & 63, wave = __builtin_amdgcn_readfirstlane(tid >> 6), gw = bid * NWAVES + wave, NGW = G * NWAVES; (void)lane; (void)gw; (void)NGW
__global__ void __launch_bounds__(NTHR, 2) fwd(Args args) {
    extern __shared__ __attribute__((aligned(16))) unsigned char lds_raw[];
    LAS unsigned char* lds = (LAS unsigned char*)lds_raw;
    volatile LAS unsigned* MISC = (volatile LAS unsigned*)(lds + MISC_OFF);
    const int wave0 = __builtin_amdgcn_readfirstlane((int)threadIdx.x >> 6), bid0 = blockIdx.x, G0 = gridDim.x;

    if (threadIdx.x < 64) MISC[threadIdx.x] = 0u;
    __syncthreads();
    const int lo = args.ph_lo, hi = args.ph_hi, rep_mask = args.rep_mask;
    XcdBarrier bar; bar.bar = (unsigned*)(args.ws + WS_CTL) + CW_BAR; bar.x = 0; bar.st = nullptr;
    if (hi - lo > 1) bar = xcd_barrier_post((unsigned*)(args.ws + WS_CTL) + CW_BAR, MISC + 8);
#define IN(k) (lo <= (k) && (k) < hi)
#define SEAM(k) do { if (IN(k) && IN((k) + 1)) { for (int br_ = 0, nbr_ = 1 + ((rep_mask >> 16) & 1); br_ < nbr_; ++br_) { XcdBarrier b2 = bar; OPAQ(b2.bar); xcd_barrier(b2); } } } while (0)

    if (IN(0)) REPEAT(0) {
        PHASE_VIEW();
        WSP(float, MODV, WS_MODV); WSP(float, BGU, WS_BGU); WSP(bf16, WIN, WS_WIN); WSP(bf16, WOUT, WS_WOUT); WSP(bf16, WGU, WS_WGU); WSP(bf16, WDN, WS_WDN);
        for (int item = bid; item < 2 * 96; item += G) {
            const int l = item / 96, n0 = (item % 96) * 64;
            LAS float* sil = (LAS float*)lds;
            LAS float* red = (LAS float*)(lds + 69632);
            __syncthreads();
            for (int i = tid; i < 17 * 1024; i += NTHR) { const int r = i >> 10, k = i & 1023; const float cv = (r < 16) ? inp[I_C][r * 1024 + k] : inp[I_CCTX][k]; sil[i] = siluf(cv); }
            __syncthreads();
            float acc[17];
#pragma unroll
            for (int r = 0; r < 17; ++r) acc[r] = 0.f;
            const float* wp = inp[I_WMOD] + ((size_t)l * 1024 + wave * 128) * NMODC + n0 + lane;
#pragma unroll 1
            for (int k0 = 0; k0 < 128; k0 += 32) { float wv[32];
#pragma unroll
                for (int k = 0; k < 32; ++k) wv[k] = wp[(size_t)(k0 + k) * NMODC];
#pragma unroll
                for (int k = 0; k < 32; ++k)
#pragma unroll
                    for (int r = 0; r < 17; ++r) acc[r] += sil[r * 1024 + wave * 128 + k0 + k] * wv[k]; }
#pragma unroll
            for (int r = 0; r < 17; ++r) red[(wave * 17 + r) * 64 + lane] = acc[r];
            __syncthreads();
            for (int i = tid; i < 17 * 64; i += NTHR) { const int r = i >> 6, cix = i & 63; float s = inp[I_BMOD][l * NMODC + n0 + cix];
#pragma unroll
                for (int w = 0; w < 8; ++w) s += red[(w * 17 + r) * 64 + cix];
                MODV[((size_t)l * 17 + r) * NMODC + n0 + cix] = s; }
        }
        __syncthreads();
        {
            LAS float* scr = (LAS float*)(lds + wave * 16384);
            constexpr int I_GU1 = 16 * 64, I_DN1 = 16 * 32, I_IN1 = 16 * 96, I_OUT1 = 16 * 32;
            constexpr int N_GU = 64 * I_GU1, N_DN = 64 * I_DN1, N_IN = 2 * I_IN1, N_OUT = 2 * I_OUT1;
            for (int it = gw; it < N_GU + N_DN + N_IN + N_OUT; it += NGW) {
                int r = it;
                if (r < N_GU) { const int mtx = r / I_GU1; tr_item<1>(inp[I_WGU] + (size_t)mtx * 1024 * 2048, 1024, 2048, WGU + (size_t)mtx * 2048 * 1024, scr, r % I_GU1, 64, lane); continue; } r -= N_GU;
                if (r < N_DN) { const int mtx = r / I_DN1; tr_item<0>(inp[I_WDN] + (size_t)mtx * 1024 * 1024, 1024, 1024, WDN + (size_t)mtx * 1024 * 1024, scr, r % I_DN1, 32, lane); continue; } r -= N_DN;
                if (r < N_IN) { const int mtx = r / I_IN1; tr_item<0>(inp[I_WIN] + (size_t)mtx * 1024 * NIN, 1024, NIN, WIN + (size_t)mtx * NINP * 1024, scr, r % I_IN1, 96, lane); continue; } r -= N_IN;
                { const int mtx = r / I_OUT1; tr_item<0>(inp[I_WOUT] + (size_t)mtx * 1024 * 1024, 1024, 1024, WOUT + (size_t)mtx * 1024 * 1024, scr, r % I_OUT1, 32, lane); }
            }
        }
        { WSP(bf16, RWH, WS_RWH); WSP(bf16, RWL, WS_RWL);
          for (int i = bid * NTHR + tid; i < 2 * 32 * 1024; i += G * NTHR) { const int k = i & 1023, e = (i >> 10) & 31, l2 = i >> 15;
              const float w = inp[I_RW][((size_t)l2 * 1024 + k) * 32 + e]; const unsigned hi16 = f2bf(w); RWH[i] = (bf16)hi16; RWL[i] = (bf16)f2bf(w - __builtin_bit_cast(float, hi16 << 16)); } }
        { WSP(bf16, WUQF, WS_WUQF); WSP(bf16, WUKVF, WS_WUKVF);
          for (int i = bid * NTHR + tid; i < 2 * 384 * 256; i += G * NTHR) { const int k = i & 255, n = (i >> 8) % 384, l2 = i / (384 * 256);
              WUQF[i] = (bf16)f2bf(inp[I_WUQ][((size_t)l2 * 256 + k) * 384 + n] * inp[I_QANORM][l2 * 256 + k]); }
          for (int i = bid * NTHR + tid; i < 2 * 512 * 128; i += G * NTHR) { const int k = i & 127, n = (i >> 7) & 511, l2 = i >> 16;
              WUKVF[i] = (bf16)f2bf(inp[I_WUKV][((size_t)l2 * 128 + k) * 512 + n] * inp[I_KVANORM][l2 * 128 + k]); } }
        for (int i = bid * NTHR + tid; i < 2 * 32 * 2048; i += G * NTHR) { const int np = i & 2047, le = i >> 11; const int pn = np >> 8, bj = (np >> 7) & 1, j = np & 127;
            BGU[i] = inp[I_BGU][(size_t)le * 2048 + 2 * (128 * pn + j) + bj]; }
    }
    SEAM(0);

    if (IN(1)) {
        PHASE_VIEW();
        WSP(float, MODV, WS_MODV); WSP(bf16, H, WS_H);
        for (int row = gw; row < MT; row += NGW) {
            const float* xr = (row < ML) ? inp[I_X] + (size_t)row * D : inp[I_CTX] + (size_t)(row - ML) * D;
            const int b = (row < ML) ? row / SEQ : NB;
            f32x4 v[4];
#pragma unroll
            for (int j = 0; j < 4; ++j) v[j] = *(const f32x4*)(xr + j * 256 + lane * 4);
            const float* mv = MODV + (size_t)b * NMODC;
            norm_mod_row(v, inp[I_NORM1], mv + 0 * D, mv + 1 * D, H + (size_t)row * D, lane);
        }
    }
    SEAM(1);

    constexpr int NPL = 9;
    for (int l = 0; l < 2; ++l) {
        const int pb = 2 + l * NPL;
        const int MROWS = (l == 0) ? MT : ML;

        if (IN(pb + 0)) REPEAT(2) {
            PHASE_VIEW();
            WSP(bf16, H, WS_H); WSP(bf16, WIN, WS_WIN); WSP(bf16, P, WS_P);
            pg8::Gemm g{H, WIN + (size_t)l * NINP * 1024, MT, NINP, 1024}; pg8::StaticOrder S; S.init(MT, NINP, G, bid);
            pg8::EpiStoreBf16 E{P, NINP};
            pg8::gemm_phase<pg8::EpiStoreBf16, pg8::StaticOrder, true, true>(lds, g, S, E, wave0, 1 + ((rep_mask >> 22) & 1));
        }
        SEAM(pb + 0);

        if (IN(pb + 1)) REPEAT(3) {
            PHASE_VIEW();
            WSP(bf16, P, WS_P);
            REPEAT(13) {
                WSP(bf16, QA, WS_QA); WSP(bf16, KA, WS_KA); WSP(bf16, VAT, WS_VA);
                const float* qn = inp[I_SWAQN] + l * 64; const float* kn = inp[I_SWAKN] + l * 64;
                const int d0 = (lane & 15) * 4;
                const f32x4 gq4 = *(const f32x4*)(qn + d0), gk4 = *(const f32x4*)(kn + d0);
                const int ax = d0 >> 5, ph = (d0 >> 4) & 1, f0 = d0 & 15;
                float fr4[4];
#pragma unroll
                for (int i = 0; i < 4; ++i) fr4[i] = exp2f(-(float)(f0 + i) * (13.287712379549449f / 16.f));
                LAS bf16* vtw = (LAS bf16*)(lds + wave * 9216);
                for (int grp = wave * G + bid; grp < MT / 32; grp += NGW) {
                    const int row0 = grp * 32; const bool lat = row0 < ML;
                    const int b = lat ? (row0 >> 11) : ((row0 - ML) >> 8); const int kk0 = lat ? (CL + (row0 & (SEQ - 1))) : ((row0 - ML) & (CL - 1));
                    v2u rq[4], rk[4]; bf16 rv[4][2];
#pragma unroll
                    for (int u = 0; u < 4; ++u) { const bf16* pr = P + (size_t)(row0 + u) * NINP; rq[u] = *(const v2u*)(pr + PC_AQ + 4 * lane); rk[u] = *(const v2u*)(pr + PC_AK + 4 * (lane & 31));
                        rv[u][0] = pr[PC_AV + lane]; rv[u][1] = pr[PC_AV + 64 + lane]; }
#pragma unroll 1
                    for (int tb = 0; tb < 8; ++tb) {
                        v2u nq[4], nk[4]; bf16 nv[4][2];
                        const int rn = row0 + ((tb + 1) & 7) * 4;
#pragma unroll
                        for (int u = 0; u < 4; ++u) { const bf16* pr = P + (size_t)(rn + u) * NINP; nq[u] = *(const v2u*)(pr + PC_AQ + 4 * lane); nk[u] = *(const v2u*)(pr + PC_AK + 4 * (lane & 31));
                            nv[u][0] = pr[PC_AV + lane]; nv[u][1] = pr[PC_AV + 64 + lane]; }
#pragma unroll
                        for (int u = 0; u < 4; ++u) {
                            const int ti = tb * 4 + u; const int row = row0 + ti; const int t = row & (SEQ - 1);
                            const float pos = (float)(ax == 0 ? (t >> 6) : (t & 63));
                            float cs[4], sn[4];
#pragma unroll
                            for (int i = 0; i < 4; ++i) { const float ang = pos * fr4[i]; cs[i] = __cosf(ang); sn[i] = __sinf(ang); }
#pragma unroll
                            for (int isk = 0; isk < 2; ++isk) {
                                const v2u raw = isk ? rk[u] : rq[u];
                                float x[4] = {bflo(raw.x), bfhi(raw.x), bflo(raw.y), bfhi(raw.y)};
                                float ss = (x[0] * x[0] + x[1] * x[1]) + (x[2] * x[2] + x[3] * x[3]);
                                ss += __shfl_xor(ss, 1); ss += __shfl_xor(ss, 2); ss += __shfl_xor(ss, 4); ss += __shfl_xor(ss, 8);
                                const float rs = rsqrtf(ss * (1.f / 64.f) + EPS);
                                const f32x4 gg = isk ? gk4 : gq4;
                                float y[4], yp[4];
#pragma unroll
                                for (int i = 0; i < 4; ++i) { y[i] = x[i] * rs * gg[i]; yp[i] = __shfl_xor(y[i], 4); }
                                if (lat) {
#pragma unroll
                                    for (int i = 0; i < 4; ++i) y[i] = (ph == 0) ? (y[i] * cs[i] - yp[i] * sn[i]) : (y[i] * cs[i] + yp[i] * sn[i]); }
                                v2u o; o.x = pk2(y[0], y[1]); o.y = pk2(y[2], y[3]);
                                if (!isk) *(v2u*)(QA + (size_t)row * 256 + 4 * lane) = o;
                                else if (lane < 32) *(v2u*)(KA + ((size_t)(b * 2 + (lane >> 4)) * KT + kk0 + ti) * 64 + d0) = o;
                            }
                            const int pp = ((ti & 12) << 1) | ((ti & 16) >> 2) | (ti & 3);
                            vtw[lane * 36 + pp] = rv[u][0]; vtw[(64 + lane) * 36 + pp] = rv[u][1];
                        }
#pragma unroll
                        for (int u = 0; u < 4; ++u) { rq[u] = nq[u]; rk[u] = nk[u]; rv[u][0] = nv[u][0]; rv[u][1] = nv[u][1]; }
                    }
                    asm volatile("s_waitcnt lgkmcnt(0)" ::: "memory");
#pragma unroll
                    for (int hk = 0; hk < 2; ++hk) { const LAS bf16* src = vtw + (hk * 64 + lane) * 36; bf16* dst = VAT + ((size_t)(b * 2 + hk) * 64 + lane) * KT + kk0;
#pragma unroll
                        for (int q4 = 0; q4 < 4; ++q4) { const v2u a0 = *(const LAS v2u*)(src + 8 * q4), a1 = *(const LAS v2u*)(src + 8 * q4 + 4); v4u o; o.x = a0.x; o.y = a0.y; o.z = a1.x; o.w = a1.y; *(v4u*)(dst + 8 * q4) = o; } }
                    asm volatile("s_waitcnt lgkmcnt(0)" ::: "memory");
                }
            }
            __syncthreads();
            REPEAT(14) {
                WSP(bf16, GW, WS_GW); WSP(bf16, GQD, WS_GQD); WSP(bf16, GKDT, WS_GKDT); WSP(bf16, GQKM, WS_GQKM); WSP(bf16, GUT, WS_GUT); WSP(float, GGE, WS_GGE);
                const float* cw = inp[I_CONV] + (size_t)l * 5 * 1536;
                LAS float* VF = (LAS float*)lds;
                LAS bf16* Qb = (LAS bf16*)(lds + 32768);
                LAS bf16* Kb = (LAS bf16*)(lds + 51200);
                LAS bf16* LH = (LAS bf16*)(lds + 69632);
                LAS bf16* LL = (LAS bf16*)(lds + 69632 + 18432);
                LAS bf16* TH = (LAS bf16*)(lds + 69632 + 36864);
                LAS bf16* TL = (LAS bf16*)(lds + 69632 + 47104);
                LAS float* GC = (LAS float*)(lds + 147456);
                LAS float* BT = GC + 128;
                const int c = lane & 15, g = lane >> 4;
                for (int item = bid; item < NB * 4 * 36; item += G) {
                    const int b = item / 144, hh = (item / 36) & 3, ct = item % 36;
                    const bool latc = ct >= 4; const int p0 = latc ? 64 * (ct - 4) : 64 * ct; const int Ls = latc ? SEQ : CL;
                    const int rowbase = latc ? b * SEQ + p0 : ML + b * CL + p0;
                    __syncthreads();
                    int tidl = tid; asm volatile("" : "+v"(tidl));
                    REPEAT(17) {
                        const int wv = __builtin_amdgcn_readfirstlane(tidl >> 6), ln = tidl & 63;
                        if (wv < 6) {
                            const int which = wv % 3, part = wv / 3, ch = which * 512 + hh * 128 + 2 * ln;
                            float w0[5], w1[5];
#pragma unroll
                            for (int w = 0; w < 5; ++w) { w0[w] = cw[w * 1536 + ch]; w1[w] = cw[w * 1536 + ch + 1]; }
                            unsigned xin[36];
#pragma unroll
                            for (int j = 0; j < 36; ++j) { const int tl = 32 * part - 2 + j; const int pos = p0 + tl;
                                xin[j] = (pos >= 0 && pos < Ls) ? *(const unsigned*)(P + (size_t)(rowbase + tl) * NINP + PC_GQ + ch) : 0u; }
                            float y0[32], y1[32];
#pragma unroll
                            for (int j = 0; j < 32; ++j) { float a0 = 0.f, a1 = 0.f;
#pragma unroll
                                for (int w = 0; w < 5; ++w) { a0 += bflo(xin[j + w]) * w0[w]; a1 += bfhi(xin[j + w]) * w1[w]; }
                                y0[j] = siluf(a0); y1[j] = siluf(a1); }
                            if (which == 2) {
#pragma unroll
                                for (int j = 0; j < 32; ++j) *(LAS f32x2_t*)(VF + (32 * part + j) * 128 + 2 * ln) = (f32x2_t){y0[j], y1[j]};
                            } else {
                                float p[32];
#pragma unroll
                                for (int j = 0; j < 32; ++j) p[j] = y0[j] * y0[j] + y1[j] * y1[j];
#pragma unroll
                                for (int k = 0; k < 5; ++k) { const bool bit = (ln >> k) & 1;
#pragma unroll
                                    for (int i = 0; i < (16 >> k); ++i) { const float keep = bit ? p[2 * i + 1] : p[2 * i], give = bit ? p[2 * i] : p[2 * i + 1]; p[i] = keep + __shfl_xor(give, 1 << k); } }
                                const float tot = p[0] + __shfl_xor(p[0], 32);
                                const float scl = rsqrtf(tot + EPS) * (which == 0 ? 0.08838834764831845f : 1.f);
                                LAS bf16* dstb = (which == 0 ? Qb : Kb) + (32 * part) * 144 + 2 * ln;
#pragma unroll
                                for (int j = 0; j < 32; ++j) { const float sj = __builtin_bit_cast(float, __builtin_amdgcn_readlane(__builtin_bit_cast(int, scl), j));
                                    *(LAS unsigned*)(dstb + j * 144) = pk2(y0[j] * sj, y1[j] * sj); }
                            }
                        } else {
                            const int dd = wv - 6, tl = dd ? 63 - ln : ln; const bf16* pr = P + (size_t)(rowbase + tl) * NINP;
                            const float a = bf2f(pr[PC_GA + dd * 4 + hh]) + inp[I_DTB][l * 8 + dd * 4 + hh];
                            const float ea = __expf(a); const float sp = (a > 20.f) ? a : ((a < -9.f) ? ea * (1.f - 0.5f * ea) : __logf(1.f + ea));
                            float gv = -__expf(inp[I_ALOG][l * 8 + dd * 4 + hh]) * sp;
                            BT[dd * 64 + ln] = 1.f / (1.f + __expf(-bf2f(pr[PC_GB + dd * 4 + hh])));
#pragma unroll
                            for (int off = 1; off < 64; off <<= 1) { const float tv = __shfl_up(gv, off); if (ln >= off) gv += tv; }
                            GC[dd * 64 + ln] = gv;
                        }
                    }
                    __syncthreads();
                    const int cs0 = ct, cs1 = (ct < 4) ? 3 - ct : 39 - ct;
                    const size_t it0 = ((size_t)(0 * NB + b) * 4 + hh) * 36 + cs0, it1 = ((size_t)(1 * NB + b) * 4 + hh) * 36 + cs1;
                    REPEAT(18) {
                        const int wv = __builtin_amdgcn_readfirstlane(tidl >> 6), c = tidl & 15, g = (tidl >> 4) & 3; const int mb = wv >> 1, nb0 = 2 * (wv & 1);
                        bf16x8_t ka[4];
#pragma unroll
                        for (int ks = 0; ks < 4; ++ks) ka[ks] = *(const LAS bf16x8_t*)(Kb + (16 * mb + c) * 144 + 32 * ks + 8 * g);
#pragma unroll
                        for (int nbi = 0; nbi < 2; ++nbi) { const int nb = nb0 + nbi;
                            f32x4 kk = (f32x4){0.f, 0.f, 0.f, 0.f}, qk = (f32x4){0.f, 0.f, 0.f, 0.f};
#pragma unroll
                            for (int ks = 0; ks < 4; ++ks) { const bf16x8_t kb = *(const LAS bf16x8_t*)(Kb + (16 * nb + c) * 144 + 32 * ks + 8 * g), qb = *(const LAS bf16x8_t*)(Qb + (16 * nb + c) * 144 + 32 * ks + 8 * g);
                                kk = __builtin_amdgcn_mfma_f32_16x16x32_bf16(ka[ks], kb, kk, 0, 0, 0); qk = __builtin_amdgcn_mfma_f32_16x16x32_bf16(ka[ks], qb, qk, 0, 0, 0); }
                            asm volatile("" ::: "memory");
#pragma unroll
                            for (int dd = 0; dd < 2; ++dd) {
                                const int s = dd ? 63 - 16 * nb - c : 16 * nb + c, ip0 = dd ? 60 - 16 * mb - 4 * g : 16 * mb + 4 * g;
                                const float gs = GC[dd * 64 + s], bs = BT[dd * 64 + s]; const f32x4 gi = *(const LAS f32x4*)(GC + dd * 64 + ip0);
                                float lv[4], qv[4];
#pragma unroll
                                for (int j = 0; j < 4; ++j) { const int ip = ip0 + j; const float dec = (ip <= s) ? __expf(gs - gi[j]) : 0.f; const int i = dd ? 3 - j : j;
                                    lv[j] = (ip < s) ? bs * kk[i] * dec : 0.f; qv[j] = qk[i] * dec; }
                                v2u h, lo; h.x = pk2(lv[0], lv[1]); h.y = pk2(lv[2], lv[3]);
                                lo.x = pk2(lv[0] - __builtin_bit_cast(float, h.x << 16), lv[1] - __builtin_bit_cast(float, h.x & 0xffff0000u));
                                lo.y = pk2(lv[2] - __builtin_bit_cast(float, h.y << 16), lv[3] - __builtin_bit_cast(float, h.y & 0xffff0000u));
                                *(LAS v2u*)(LH + (dd * 64 + s) * 72 + ip0) = h; *(LAS v2u*)(LL + (dd * 64 + s) * 72 + ip0) = lo;
                                v2u qo; qo.x = pk2(qv[0], qv[1]); qo.y = pk2(qv[2], qv[3]);
                                *(v2u*)(GQKM + (dd ? it1 : it0) * 4096 + (((s >> 4) * 2 + (ip0 >> 5)) * 64 + ((ip0 & 31) >> 3) * 16 + (s & 15)) * 8 + (ip0 & 7)) = qo; }
                        }
                    }
                    __syncthreads();
                    REPEAT(19) {
                        const int wv = __builtin_amdgcn_readfirstlane(tidl >> 6), ln = tidl & 63; const int dd = wv >> 2, blk = wv & 3;
                        if (ln < 16) { float t[16];
#pragma unroll
                            for (int r = 0; r < 16; ++r) { float acc = (r == ln) ? 1.f : 0.f;
                                const int off = (dd * 64 + 16 * blk + r) * 72 + 16 * blk;
                                if (r > 0) { const v4u h0 = *(const LAS v4u*)(LH + off), l0 = *(const LAS v4u*)(LL + off);
#pragma unroll
                                    for (int i = 0; i < (r < 8 ? r : 8); ++i) { const unsigned hw = h0[i >> 1], lw = l0[i >> 1]; acc -= ((i & 1) ? bfhi(hw) + bfhi(lw) : bflo(hw) + bflo(lw)) * t[i]; } }
                                if (r > 8) { const v4u h1 = *(const LAS v4u*)(LH + off + 8), l1 = *(const LAS v4u*)(LL + off + 8);
#pragma unroll
                                    for (int i = 8; i < r; ++i) { const unsigned hw = h1[(i - 8) >> 1], lw = l1[(i - 8) >> 1]; acc -= ((i & 1) ? bfhi(hw) + bfhi(lw) : bflo(hw) + bflo(lw)) * t[i]; } }
                                t[r] = acc; }
#pragma unroll
                            for (int r = 0; r < 16; ++r) { const unsigned hi16 = f2bf(t[r]); const int off = ((dd * 4 + blk) * 16 + r) * 40 + ln;
                                TH[off] = (bf16)hi16; TL[off] = (bf16)f2bf(t[r] - __builtin_bit_cast(float, hi16 << 16)); } }
                    }
                    __syncthreads();
                    REPEAT(20) {
                        const int wv = __builtin_amdgcn_readfirstlane(tidl >> 6), ln = tidl & 63, c = ln & 15, g = ln >> 4; const int dd = wv >> 2;
                        const size_t itd = dd ? it1 : it0;
                        const int ct0 = 4 * (wv & 3);
                        auto solve = [&](auto isu_c) {
                        constexpr bool isu = decltype(isu_c)::value;
                        v2u xb[4][4];
#pragma unroll
                        for (int q = 0; q < 4; ++q)
#pragma unroll
                            for (int k = 0; k < 4; ++k) xb[q][k] = (v2u){0u, 0u};
#pragma unroll
                        for (int blk = 0; blk < 4; ++blk) {
                            const int arow = (dd * 64 + 16 * blk + c) * 72 + 4 * g;
                            v4u ah[2], al[2];
#pragma unroll
                            for (int ch = 0; ch < 2; ++ch) if ((ch == 0 && blk >= 1) || (ch == 1 && blk == 3)) {
                                const v2u a0 = *(const LAS v2u*)(LH + arow + 32 * ch), a1 = *(const LAS v2u*)(LH + arow + 32 * ch + 16), b0 = *(const LAS v2u*)(LL + arow + 32 * ch), b1 = *(const LAS v2u*)(LL + arow + 32 * ch + 16);
                                ah[ch] = (v4u){a0.x, a0.y, a1.x, a1.y}; al[ch] = (v4u){b0.x, b0.y, b1.x, b1.y}; }
                            const int toff = ((dd * 4 + blk) * 16 + c) * 40 + 4 * g;
                            const v2u t0 = *(const LAS v2u*)(TH + toff), t1 = *(const LAS v2u*)(TL + toff);
                            const bf16x8_t th = __builtin_bit_cast(bf16x8_t, ((v4u){t0.x, t0.y, 0u, 0u})), tlw = __builtin_bit_cast(bf16x8_t, ((v4u){t1.x, t1.y, 0u, 0u}));
                            const f32x4 bt4 = *(const LAS f32x4*)(BT + dd * 64 + 16 * blk + 4 * g), gc4 = *(const LAS f32x4*)(GC + dd * 64 + 16 * blk + 4 * g);
                            float sc[4];
#pragma unroll
                            for (int i = 0; i < 4; ++i) sc[i] = isu ? bt4[i] : bt4[i] * __expf(gc4[i]);
                            f32x4 rhs[4];
#pragma unroll
                            for (int q = 0; q < 4; ++q) { const int cl = (16 * (ct0 + q) + c) & 127;
#pragma unroll
                                for (int i = 0; i < 4; ++i) { const int s = 16 * blk + 4 * g + i, tl = dd ? 63 - s : s;
                                    float rv; if constexpr (isu) rv = VF[tl * 128 + cl]; else rv = bf2f(Kb[tl * 144 + cl]);
                                    rhs[q][i] = sc[i] * rv; } }
#pragma unroll
                            for (int q = 0; q < 4; ++q) {
                                const int ctile = ct0 + q;
                                f32x4 prod = (f32x4){0.f, 0.f, 0.f, 0.f};
#pragma unroll
                                for (int ch = 0; ch < 2; ++ch) if ((ch == 0 && blk >= 1) || (ch == 1 && blk == 3)) {
                                    const bf16x8_t xbf = __builtin_bit_cast(bf16x8_t, ((v4u){xb[q][2 * ch].x, xb[q][2 * ch].y, xb[q][2 * ch + 1].x, xb[q][2 * ch + 1].y}));
                                    prod = __builtin_amdgcn_mfma_f32_16x16x32_bf16(__builtin_bit_cast(bf16x8_t, ah[ch]), xbf, prod, 0, 0, 0);
                                    prod = __builtin_amdgcn_mfma_f32_16x16x32_bf16(__builtin_bit_cast(bf16x8_t, al[ch]), xbf, prod, 0, 0, 0); }
                                const f32x4 y = rhs[q] - prod;
                                const bf16x8_t yb = __builtin_bit_cast(bf16x8_t, ((v4u){pk2(y.x, y.y), pk2(y.z, y.w), 0u, 0u}));
                                f32x4 x = (f32x4){0.f, 0.f, 0.f, 0.f};
                                x = __builtin_amdgcn_mfma_f32_16x16x32_bf16(th, yb, x, 0, 0, 0); x = __builtin_amdgcn_mfma_f32_16x16x32_bf16(tlw, yb, x, 0, 0, 0);
                                xb[q][blk].x = pk2(x.x, x.y); xb[q][blk].y = pk2(x.z, x.w);
                                if constexpr (isu) *(v2u*)(GUT + itd * 8192 + ((ctile * 4 + blk) * 64 + ln) * 4) = xb[q][blk];
                                else {
                                    f32x4 xt = (f32x4){0.f, 0.f, 0.f, 0.f};
                                    xt = __builtin_amdgcn_mfma_f32_16x16x32_bf16(yb, th, xt, 0, 0, 0); xt = __builtin_amdgcn_mfma_f32_16x16x32_bf16(yb, tlw, xt, 0, 0, 0);
                                    const int kd0 = 16 * (ctile - 8) + 4 * g; v2u o; o.x = pk2(xt.x, xt.y); o.y = pk2(xt.z, xt.w);
                                    *(v2u*)(GW + itd * 8192 + ((blk * 4 + (kd0 >> 5)) * 64 + ((kd0 & 31) >> 3) * 16 + c) * 8 + (kd0 & 7)) = o; }
                            }
                        }
                        };
                        if ((wv & 2) == 0) solve(std::true_type{}); else solve(std::false_type{});
                    }
                    REPEAT(21) {
                        WSP(bf16, GQN, WS_GQD); WSP(bf16, GKT, WS_GKDT); float* GCG = (float*)(wsb + WS_GQD + 40 * MiB);
                        const size_t iq = (size_t)(b * 4 + hh) * 36 + ct;
                        for (int f = tidl; f < 1024; f += NTHR) { const int mbq = f >> 8, ksq = (f >> 6) & 3, r = f & 15, gg = (f >> 4) & 3;
                            *(v4u*)(GQN + iq * 8192 + (size_t)f * 8) = *(const LAS v4u*)(Qb + (16 * mbq + r) * 144 + 32 * ksq + 8 * gg); }
                        for (int f = tidl; f < 1024; f += NTHR) { const int kbq = f >> 7, ksq = (f >> 6) & 1, r = f & 15, gg = (f >> 4) & 3; const int kd = 16 * kbq + r, tb = 32 * ksq + 8 * gg;
                            v4u o; o.x = (unsigned)Kb[(tb + 0) * 144 + kd] | ((unsigned)Kb[(tb + 1) * 144 + kd] << 16); o.y = (unsigned)Kb[(tb + 2) * 144 + kd] | ((unsigned)Kb[(tb + 3) * 144 + kd] << 16);
                            o.z = (unsigned)Kb[(tb + 4) * 144 + kd] | ((unsigned)Kb[(tb + 5) * 144 + kd] << 16); o.w = (unsigned)Kb[(tb + 6) * 144 + kd] | ((unsigned)Kb[(tb + 7) * 144 + kd] << 16);
                            *(v4u*)(GKT + iq * 8192 + (size_t)f * 8) = o; }
                        if (tidl < 128) GCG[((tidl >> 6) ? it1 : it0) * 64 + (tidl & 63)] = GC[tidl];
                    }
                }
            }
            __syncthreads();
            REPEAT(15) {
                WSP(bf16, QM, WS_QM); WSP(bf16, KM, WS_KM); WSP(bf16, VMT, WS_VM);
                const int per = (MT + G - 1) / G, r0 = bid * per, r1 = (r0 + per < MT) ? r0 + per : MT, ngrp = (r1 - r0 + 15) >> 4;
                LAS float* ssq = (LAS float*)lds;
                {
                    int ln_ = tid; asm volatile("" : "+v"(ln_)); const int c = ln_ & 15, g = (ln_ >> 4) & 3;
                    const float* gq = inp[I_MQN] + l * 96; WSP(bf16, WUQF, WS_WUQF);
                    bf16x8_t wf[3][8];
#pragma unroll
                    for (int nb = 0; nb < 3; ++nb)
#pragma unroll
                        for (int ks = 0; ks < 8; ++ks) wf[nb][ks] = *(const bf16x8_t*)(WUQF + ((size_t)l * 384 + 48 * wave + 16 * nb + c) * 256 + 32 * ks + 8 * g);
                    const int hh = wave >> 1, dbase = 48 * (wave & 1);
                    v4u nraw[8];
                    { const int rw = (r0 + c < r1) ? r0 + c : r1 - 1; const bf16* pr = P + (size_t)rw * NINP + PC_CQ + 8 * g;
#pragma unroll
                      for (int ks = 0; ks < 8; ++ks) nraw[ks] = *(const v4u*)(pr + 32 * ks); }
                    for (int grp = 0; grp < ngrp; ++grp) {
                        const int rowv = r0 + 16 * grp + c; const bool valid = rowv < r1; const int row = valid ? rowv : r1 - 1;
                        v4u craw[8];
#pragma unroll
                        for (int ks = 0; ks < 8; ++ks) craw[ks] = nraw[ks];
                        if (grp + 1 < ngrp) { const int rn = (rowv + 16 < r1) ? rowv + 16 : r1 - 1; const bf16* prn = P + (size_t)rn * NINP + PC_CQ + 8 * g;
#pragma unroll
                            for (int ks = 0; ks < 8; ++ks) nraw[ks] = *(const v4u*)(prn + 32 * ks); }
                        bf16x8_t xf[8]; float ss = 0.f;
#pragma unroll
                        for (int ks = 0; ks < 8; ++ks) { const v4u raw = craw[ks]; xf[ks] = __builtin_bit_cast(bf16x8_t, raw);
                            ss += bflo(raw.x) * bflo(raw.x) + bfhi(raw.x) * bfhi(raw.x) + bflo(raw.y) * bflo(raw.y) + bfhi(raw.y) * bfhi(raw.y)
                                + bflo(raw.z) * bflo(raw.z) + bfhi(raw.z) * bfhi(raw.z) + bflo(raw.w) * bflo(raw.w) + bfhi(raw.w) * bfhi(raw.w); }
                        ss += __shfl_xor(ss, 16); ss += __shfl_xor(ss, 32);
                        const float rstd = rsqrtf(ss * (1.f / 256.f) + EPS);
                        f32x4 acc[3]; float hs = 0.f;
#pragma unroll
                        for (int nb = 0; nb < 3; ++nb) { acc[nb] = (f32x4){0.f, 0.f, 0.f, 0.f};
#pragma unroll
                            for (int ks = 0; ks < 8; ++ks) acc[nb] = __builtin_amdgcn_mfma_f32_16x16x32_bf16(wf[nb][ks], xf[ks], acc[nb], 0, 0, 0);
                            acc[nb] = acc[nb] * rstd; hs += (acc[nb].x * acc[nb].x + acc[nb].y * acc[nb].y) + (acc[nb].z * acc[nb].z + acc[nb].w * acc[nb].w); }
                        hs += __shfl_xor(hs, 16); hs += __shfl_xor(hs, 32);
                        LAS float* sq = ssq + (grp & 1) * 128;
                        if (g == 0) sq[wave * 16 + c] = hs;
                        __syncthreads();
                        const float rs = rsqrtf((sq[wave * 16 + c] + sq[(wave ^ 1) * 16 + c]) * (1.f / 96.f) + EPS);
                        const bool lat = row < ML; const int t = row & (SEQ - 1);
#pragma unroll
                        for (int nb = 0; nb < 3; ++nb) { const int d0 = dbase + 16 * nb + 4 * g;
                            const f32x4 gv = *(const f32x4*)(gq + d0);
                            f32x4 y = acc[nb] * rs * gv;
                            if (d0 >= 64) {
                                f32x4 yp; yp.x = __shfl_xor(y.x, 32); yp.y = __shfl_xor(y.y, 32); yp.z = __shfl_xor(y.z, 32); yp.w = __shfl_xor(y.w, 32);
                                if (lat) { const int r = d0 - 64; const int ax = r >> 4, ph = (r >> 3) & 1; const float pos = (float)(ax == 0 ? (t >> 6) : (t & 63));
#pragma unroll
                                    for (int i = 0; i < 4; ++i) { const float ang = pos * exp2f(-(float)((r & 7) + i) * (13.287712379549449f / 8.f)); const float cs = __cosf(ang), sn = __sinf(ang);
                                        y[i] = (ph == 0) ? (y[i] * cs - yp[i] * sn) : (y[i] * cs + yp[i] * sn); } } }
                            if (valid) { v2u o; o.x = pk2(y.x, y.y); o.y = pk2(y.z, y.w); *(v2u*)(QM + (size_t)row * 384 + hh * 96 + d0) = o; } }
                    }
                }
                __syncthreads();
                {
                    int ln_ = tid; asm volatile("" : "+v"(ln_)); const int c = ln_ & 15, g = (ln_ >> 4) & 3;
                    const float* gk = inp[I_MKN] + l * 96; WSP(bf16, WUKVF, WS_WUKVF);
                    bf16x8_t wf[4][4];
#pragma unroll
                    for (int nb = 0; nb < 4; ++nb)
#pragma unroll
                        for (int ks = 0; ks < 4; ++ks) wf[nb][ks] = *(const bf16x8_t*)(WUKVF + ((size_t)l * 512 + 64 * wave + 16 * nb + c) * 128 + 32 * ks + 8 * g);
                    const int hh = wave >> 1;
                    v4u nraw[4], nrr;
                    { const int rw = (r0 + c < r1) ? r0 + c : r1 - 1; const bf16* pr = P + (size_t)rw * NINP + PC_CKV + 8 * g;
#pragma unroll
                      for (int ks = 0; ks < 4; ++ks) nraw[ks] = *(const v4u*)(pr + 32 * ks);
                      nrr = *(const v4u*)(P + (size_t)rw * NINP + PC_CKR + 8 * g); }
                    for (int grp = 0; grp < ngrp; ++grp) {
                        const int rowv = r0 + 16 * grp + c; const bool valid = rowv < r1; const int row = valid ? rowv : r1 - 1;
                        v4u craw[4]; const v4u rr = nrr;
#pragma unroll
                        for (int ks = 0; ks < 4; ++ks) craw[ks] = nraw[ks];
                        if (grp + 1 < ngrp) { const int rn = (rowv + 16 < r1) ? rowv + 16 : r1 - 1; const bf16* prn = P + (size_t)rn * NINP + PC_CKV + 8 * g;
#pragma unroll
                            for (int ks = 0; ks < 4; ++ks) nraw[ks] = *(const v4u*)(prn + 32 * ks);
                            nrr = *(const v4u*)(P + (size_t)rn * NINP + PC_CKR + 8 * g); }
                        bf16x8_t xf[4]; float ss = 0.f;
#pragma unroll
                        for (int ks = 0; ks < 4; ++ks) { const v4u raw = craw[ks]; xf[ks] = __builtin_bit_cast(bf16x8_t, raw);
                            ss += bflo(raw.x) * bflo(raw.x) + bfhi(raw.x) * bfhi(raw.x) + bflo(raw.y) * bflo(raw.y) + bfhi(raw.y) * bfhi(raw.y)
                                + bflo(raw.z) * bflo(raw.z) + bfhi(raw.z) * bfhi(raw.z) + bflo(raw.w) * bflo(raw.w) + bfhi(raw.w) * bfhi(raw.w); }
                        ss += __shfl_xor(ss, 16); ss += __shfl_xor(ss, 32);
                        const float rstd = rsqrtf(ss * (1.f / 128.f) + EPS);
                        f32x4 acc[4]; float hs = 0.f;
#pragma unroll
                        for (int nb = 0; nb < 4; ++nb) { acc[nb] = (f32x4){0.f, 0.f, 0.f, 0.f};
#pragma unroll
                            for (int ks = 0; ks < 4; ++ks) acc[nb] = __builtin_amdgcn_mfma_f32_16x16x32_bf16(wf[nb][ks], xf[ks], acc[nb], 0, 0, 0);
                            acc[nb] = acc[nb] * rstd; hs += (acc[nb].x * acc[nb].x + acc[nb].y * acc[nb].y) + (acc[nb].z * acc[nb].z + acc[nb].w * acc[nb].w); }
                        const bool lat = row < ML; const int t = row & (SEQ - 1);
                        const int b = lat ? (row >> 11) : ((row - ML) >> 8); const int kk = lat ? (CL + t) : ((row - ML) & (CL - 1));
                        if ((wave & 1) == 0) {
                            float kr[8] = {bflo(rr.x), bfhi(rr.x), bflo(rr.y), bfhi(rr.y), bflo(rr.z), bfhi(rr.z), bflo(rr.w), bfhi(rr.w)};
#pragma unroll
                            for (int j = 0; j < 8; ++j) hs += kr[j] * kr[j];
                            hs += __shfl_xor(hs, 16); hs += __shfl_xor(hs, 32);
                            const float rs = rsqrtf(hs * (1.f / 96.f) + EPS);
                            bf16* kd = KM + ((size_t)(b * 4 + hh) * KT + kk) * 96;
#pragma unroll
                            for (int nb = 0; nb < 4; ++nb) { const int d0 = 16 * nb + 4 * g; const f32x4 gv = *(const f32x4*)(gk + d0); const f32x4 y = acc[nb] * rs * gv;
                                if (valid) { v2u o; o.x = pk2(y.x, y.y); o.y = pk2(y.z, y.w); *(v2u*)(kd + d0) = o; } }
                            const int ax = g >> 1, ph = g & 1; const float pos = (float)(ax == 0 ? (t >> 6) : (t & 63));
                            float yr[8];
#pragma unroll
                            for (int j = 0; j < 8; ++j) { float y = kr[j] * rs * gk[64 + 8 * g + j]; const float yp = __shfl_xor(y, 16);
                                if (lat) { const float ang = pos * exp2f(-(float)j * (13.287712379549449f / 8.f)); const float cs = __cosf(ang), sn = __sinf(ang); y = (ph == 0) ? (y * cs - yp * sn) : (y * cs + yp * sn); }
                                yr[j] = y; }
                            if (valid) { v4u o; o.x = pk2(yr[0], yr[1]); o.y = pk2(yr[2], yr[3]); o.z = pk2(yr[4], yr[5]); o.w = pk2(yr[6], yr[7]); *(v4u*)(kd + 64 + 8 * g) = o; }
                        } else {
                            bf16* vd = VMT + (size_t)(b * 4 + hh) * 64 * KT + ((kk & ~31) | ((kk & 12) << 1) | ((kk & 16) >> 2) | (kk & 3));
                            if (valid) {
#pragma unroll
                                for (int nb = 0; nb < 4; ++nb)
#pragma unroll
                                    for (int i = 0; i < 4; ++i) vd[(size_t)(16 * nb + 4 * g + i) * KT] = (bf16)f2bf(acc[nb][i]); }
                        }
                    }
                }
            }
        }
        SEAM(pb + 1);

        if (IN(pb + 2)) {
            PHASE_VIEW();
            REPEAT(4) {
                WSP(bf16, GW, WS_GW); WSP(bf16, GQN, WS_GQD); WSP(bf16, GKT, WS_GKDT); WSP(bf16, GQKM, WS_GQKM); WSP(bf16, GUT, WS_GUT); WSP(bf16, OD, WS_OD); const float* GCG = (const float*)(wsb + WS_GQD + 40 * MiB);
                LAS bf16* ST = (LAS bf16*)lds;
                LAS bf16* VT = (LAS bf16*)(lds + 36864);
                LAS bf16* VT2 = (LAS bf16*)(lds + 36864 + 20480);
                const int c = lane & 15, g = lane >> 4, mb = wave >> 1, nb0 = 4 * (wave & 1);
                const bool xcdaware = (G & 7) == 0 && G >= 128;
                const int nscan = xcdaware ? 128 : (G < 128 ? G : 128), sci = xcdaware ? ((bid >> 3) < 16 ? (bid >> 3) * 8 + (bid & 7) : 128) : (bid < 128 ? bid : 128);
                for (int ci = sci; ci < 128; ci += nscan) {
                    const int idx = ci >> 3, xq = ci & 7; const int dd = idx & 1, bh = (idx >> 1) * 8 + xq, b = bh >> 2, hh = bh & 3; const int chain = (dd * 16 + b) * 4 + hh;
                    __syncthreads();
                    { unsigned z_ = 0u; asm volatile("" : "+v"(z_));
                      for (int i = tid; i < 36864 / 16; i += NTHR) *(LAS v4u*)(lds + 16 * i) = (v4u){z_, z_, z_, z_}; }
                    f32x4 Sm[8];
#pragma unroll
                    for (int nb = 0; nb < 8; ++nb) Sm[nb] = (f32x4){0.f, 0.f, 0.f, 0.f};
                    const size_t itb = (size_t)chain * 36;
                    bf16x8_t nw[4], nq[4], nm[2], nk[2]; v2u nu[4]; f32x4 ngc; float nge;
                    const unsigned o_w = (unsigned)(mb * 4) * 1024u + (unsigned)lane * 16u;
                    const unsigned o_qn = dd ? (unsigned)((3 - mb) * 4) * 1024u + (unsigned)(g * 16 + (15 - c)) * 16u : o_w;
                    const unsigned o_m = (unsigned)(mb * 2) * 1024u + (unsigned)lane * 16u, o_k = (unsigned)(wave * 2) * 1024u + (unsigned)lane * 16u;
                    const unsigned o_u0 = (unsigned)((nb0 * 4 + mb) * 64 + lane) * 8u;
#define GDN_CT(cs_) (dd ? ((cs_) < 4 ? 3 - (cs_) : 39 - (cs_)) : (cs_))
#define GDN_LOAD_A(cs_) do { const size_t it_ = itb + (cs_); const size_t iq_ = (size_t)(b * 4 + hh) * 36 + GDN_CT(cs_); const char* bw_ = (const char*)GW + it_ * (64 * 128 * 2); const char* bq_ = (const char*)GQN + iq_ * (64 * 128 * 2); \
                        _Pragma("unroll") for (int ks = 0; ks < 4; ++ks) { nw[ks] = *(const bf16x8_t*)(bw_ + o_w + ks * 1024); nq[ks] = *(const bf16x8_t*)(bq_ + o_qn + ks * 1024); } } while (0)
#define GDN_LOAD_B(cs_) do { const size_t it_ = itb + (cs_); const size_t iq_ = (size_t)(b * 4 + hh) * 36 + GDN_CT(cs_); const char* bm_ = (const char*)GQKM + it_ * (64 * 64 * 2); const char* bk_ = (const char*)GKT + iq_ * (128 * 64 * 2); const char* bu_ = (const char*)GUT + it_ * (128 * 64 * 2); \
                        _Pragma("unroll") for (int nbi = 0; nbi < 4; ++nbi) nu[nbi] = *(const v2u*)(bu_ + o_u0 + nbi * 2048); ngc = *(const f32x4*)(GCG + it_ * 64 + 16 * mb + 4 * g); nge = GCG[it_ * 64 + 63]; (void)bm_; (void)bk_; } while (0)
#define GDN_LOAD_C(cs_) do { const size_t it_ = itb + (cs_); const size_t iq_ = (size_t)(b * 4 + hh) * 36 + GDN_CT(cs_); const char* bm_ = (const char*)GQKM + it_ * (64 * 64 * 2); const char* bk_ = (const char*)GKT + iq_ * (128 * 64 * 2); \
                        _Pragma("unroll") for (int ks = 0; ks < 2; ++ks) { nm[ks] = *(const bf16x8_t*)(bm_ + o_m + ks * 1024); nk[ks] = *(const bf16x8_t*)(bk_ + o_k + ks * 1024); } } while (0)
                    GDN_LOAD_A(0); GDN_LOAD_B(0); GDN_LOAD_C(0);
                    __syncthreads();
                    for (int cs = 0; cs < 36; ++cs) {
                        bf16x8_t cw_[4], cq_[4], cm_[2], ck_[2]; v2u cu_[4];
#pragma unroll
                        for (int ks = 0; ks < 4; ++ks) { cw_[ks] = nw[ks]; cq_[ks] = nq[ks]; }
#pragma unroll
                        for (int ks = 0; ks < 2; ++ks) { cm_[ks] = nm[ks]; ck_[ks] = nk[ks]; }
#pragma unroll
                        for (int nbi = 0; nbi < 4; ++nbi) cu_[nbi] = nu[nbi];
                        const float gend = nge; const f32x4 gcv = ngc;
                        const float ge = __expf(gend);
                        f32x4 egc, egk;
#pragma unroll
                        for (int i = 0; i < 4; ++i) { egc[i] = __expf(gcv[i]); egk[i] = __expf(gend - gcv[i]); }
                        if (cs + 1 < 36) { GDN_LOAD_A(cs + 1); GDN_LOAD_B(cs + 1); }
                        f32x4 aws[4], aqs[4];
#pragma unroll
                        for (int nbi = 0; nbi < 4; ++nbi) { aws[nbi] = (f32x4){0.f, 0.f, 0.f, 0.f}; aqs[nbi] = (f32x4){0.f, 0.f, 0.f, 0.f};
#pragma unroll
                            for (int ks = 0; ks < 4; ++ks) { const bf16x8_t sf = *(const LAS bf16x8_t*)(ST + (16 * (nb0 + nbi) + c) * 144 + 32 * ks + 8 * g);
                                aws[nbi] = __builtin_amdgcn_mfma_f32_16x16x32_bf16(cw_[ks], sf, aws[nbi], 0, 0, 0); aqs[nbi] = __builtin_amdgcn_mfma_f32_16x16x32_bf16(cq_[ks], sf, aqs[nbi], 0, 0, 0); }
                            const f32x4 uu = (f32x4){bflo(cu_[nbi].x), bfhi(cu_[nbi].x), bflo(cu_[nbi].y), bfhi(cu_[nbi].y)}; const f32x4 vn = uu - aws[nbi];
                            aqs[nbi] = aqs[nbi] * egc;
                            v2u o; o.x = pk2(vn.x, vn.y); o.y = pk2(vn.z, vn.w); *(LAS v2u*)(VT + (16 * (nb0 + nbi) + c) * 80 + 16 * mb + 4 * g) = o;
                            const f32x4 vs = vn * egk;
                            v2u o2; if (dd) { o2.x = pk2(vs.w, vs.z); o2.y = pk2(vs.y, vs.x); } else { o2.x = pk2(vs.x, vs.y); o2.y = pk2(vs.z, vs.w); }
                            *(LAS v2u*)(VT2 + (16 * (nb0 + nbi) + c) * 80 + (dd ? 60 - 16 * mb - 4 * g : 16 * mb + 4 * g)) = o2; }
                        __syncthreads();
                        if (cs + 1 < 36) GDN_LOAD_C(cs + 1);
                        const int ct = dd ? (cs < 4 ? 3 - cs : 39 - cs) : cs; const int rowbase = (ct >= 4) ? b * SEQ + 64 * (ct - 4) : ML + b * CL + 64 * ct;
#pragma unroll
                        for (int nb = 0; nb < 8; ++nb) { bf16x8_t vf2[2];
#pragma unroll
                            for (int ks = 0; ks < 2; ++ks) vf2[ks] = *(const LAS bf16x8_t*)(VT2 + (16 * nb + c) * 80 + 32 * ks + 8 * g);
                            Sm[nb] = Sm[nb] * ge;
#pragma unroll
                            for (int ks = 0; ks < 2; ++ks) Sm[nb] = __builtin_amdgcn_mfma_f32_16x16x32_bf16(ck_[ks], vf2[ks], Sm[nb], 0, 0, 0); }
#pragma unroll
                        for (int nbi = 0; nbi < 4; ++nbi)
#pragma unroll
                            for (int ks = 0; ks < 2; ++ks) { const bf16x8_t vf = *(const LAS bf16x8_t*)(VT + (16 * (nb0 + nbi) + c) * 80 + 32 * ks + 8 * g);
                                aqs[nbi] = __builtin_amdgcn_mfma_f32_16x16x32_bf16(cm_[ks], vf, aqs[nbi], 0, 0, 0); }
#pragma unroll
                        for (int nbi = 0; nbi < 4; ++nbi)
#pragma unroll
                            for (int i = 0; i < 4; ++i) { const int s = 16 * mb + 4 * g + i; const int tl = dd ? 63 - s : s;
                                OD[((size_t)dd * MT + rowbase + tl) * 512 + hh * 128 + 16 * (nb0 + nbi) + c] = (bf16)f2bf(aqs[nbi][i]); }
#pragma unroll
                        for (int nb = 0; nb < 8; ++nb) { v2u o; o.x = pk2(Sm[nb].x, Sm[nb].y); o.y = pk2(Sm[nb].z, Sm[nb].w); *(LAS v2u*)(ST + (16 * nb + c) * 144 + 16 * wave + 4 * g) = o; }
                        __syncthreads();
                    }
#undef GDN_LOAD_A
#undef GDN_LOAD_B
#undef GDN_LOAD_C
#undef GDN_CT
                }
            }
            __syncthreads();
            REPEAT(5) {
                WSP(bf16, QA, WS_QA); WSP(bf16, KA, WS_KA); WSP(bf16, VAT, WS_VA); WSP(bf16, QM, WS_QM); WSP(bf16, KM, WS_KM); WSP(bf16, VMT, WS_VM); WSP(bf16, MIX, WS_MIX);
                constexpr float L2E = 1.4426950408889634f;
                const int NU_ML = NB * 4 * 8, NU_SL = NB * 4 * 8, NU_C = (l == 0) ? NB * 4 : 0;
                const int NX = (G % 8 == 0) ? 8 : 1, xx = bid % NX, BPX = G / NX, lb = bid / NX;
                const int NUx_ML = NU_ML / NX, NUx_SL = NU_SL / NX, NUx_C = NU_C / NX;
                unsigned* aq = (unsigned*)(wsb + WS_CTL) + CW_AQ + (l * 8 + xx) * 64; (void)lb; (void)BPX;
                for (;;) {
                    __syncthreads();
                    if (tid == 0) MISC[44] = __hip_atomic_fetch_add(aq, 1u, __ATOMIC_RELAXED, __HIP_MEMORY_SCOPE_AGENT);
                    __syncthreads();
                    const int li = __builtin_amdgcn_readfirstlane((int)MISC[44]);
                    if (li >= NUx_ML + NUx_SL + 2 * NUx_C) break;
                    int r = li;
                    if (r < NUx_ML) {
                        const int bh = (r >> 3) * NX + xx, qt = r & 7; const int b = bh >> 2, hh = bh & 3; const int row = b * SEQ + qt * 256;
                        attn_block<96>(lds, QM + (size_t)row * 384 + hh * 96, 384, KM + (size_t)(b * 4 + hh) * KT * 96, VMT + (size_t)(b * 4 + hh) * 64 * KT, 0, KT / 64, KT / 64, KT / 64,
                                       qt * 256, false, 0.10206207261596575f * L2E, false, 0.f, MIX + (size_t)row * D + 768 + hh * 64, tid);
                        continue; }
                    r -= NUx_ML;
                    if (r < NUx_SL) {
                        const int bk = (r >> 4) * NX + xx, hql = (r >> 3) & 1, qt = r & 7; const int b = bk >> 1, hk = bk & 1, hq = hk * 2 + hql; const int row = b * SEQ + qt * 256;
                        const int ja = (qt * 256 - 128) < 0 ? 0 : (qt * 256 - 128), jb = (qt * 256 + 384) > SEQ ? SEQ : (qt * 256 + 384);
                        attn_block<64>(lds, QA + (size_t)row * 256 + hq * 64, 256, KA + (size_t)(b * 2 + hk) * KT * 64, VAT + (size_t)(b * 2 + hk) * 64 * KT, 0, CL / 64, (CL + ja) / 64, (CL + jb) / 64,
                                       qt * 256, true, 0.125f * L2E, true, inp[I_SINK][l * 4 + hq] * L2E, MIX + (size_t)row * D + hq * 64, tid);
                        continue; }
                    r -= NUx_SL;
                    if (r < NUx_C) {
                        const int bk = (r >> 1) * NX + xx, hql = r & 1; const int b = bk >> 1, hk = bk & 1, hq = hk * 2 + hql; const int row = ML + b * CL;
                        attn_block<64>(lds, QA + (size_t)row * 256 + hq * 64, 256, KA + (size_t)(b * 2 + hk) * KT * 64, VAT + (size_t)(b * 2 + hk) * 64 * KT, 0, CL / 64, CL / 64, CL / 64,
                                       0, false, 0.125f * L2E, true, inp[I_SINK][l * 4 + hq] * L2E, MIX + (size_t)row * D + hq * 64, tid);
                        continue; }
                    r -= NUx_C;
                    {
                        const int bh = r * NX + xx; const int b = bh >> 2, hh = bh & 3; const int row = ML + b * CL;
                        attn_block<96>(lds, QM + (size_t)row * 384 + hh * 96, 384, KM + (size_t)(b * 4 + hh) * KT * 96, VMT + (size_t)(b * 4 + hh) * 64 * KT, 0, CL / 64, CL / 64, CL / 64,
                                       0, false, 0.10206207261596575f * L2E, false, 0.f, MIX + (size_t)row * D + 768 + hh * 64, tid);
                    }
                }
            }
        }
        SEAM(pb + 2);

        if (IN(pb + 3)) REPEAT(6) {
            PHASE_VIEW();
            WSP(bf16, OD, WS_OD); WSP(bf16, P, WS_P); WSP(bf16, MIX, WS_MIX);
            const float* gn = inp[I_GONORM] + l * 128;
            for (int it = gw; it < MROWS * 4; it += NGW) {
                const int row = it >> 2, hh = it & 3;
                const size_t oo = (size_t)row * 512 + hh * 128 + lane * 2;
                const unsigned of = *(const unsigned*)(OD + oo), ob = *(const unsigned*)(OD + (size_t)MT * 512 + oo); const float o0 = bflo(of) + bflo(ob), o1 = bfhi(of) + bfhi(ob);
                const float rs = rsqrtf(wave_sum(o0 * o0 + o1 * o1) * (1.f / 128.f) + EPS);
                const unsigned zz = *(const unsigned*)(P + (size_t)row * NINP + PC_GZ + hh * 128 + lane * 2);
                const float y0 = o0 * rs * gn[lane * 2] * siluf(bflo(zz)), y1 = o1 * rs * gn[lane * 2 + 1] * siluf(bfhi(zz));
                *(unsigned*)(MIX + (size_t)row * D + 256 + hh * 128 + lane * 2) = pk2(y0, y1);
            }
        }
        SEAM(pb + 3);

        if (IN(pb + 4)) {
            PHASE_VIEW();
            WSP(bf16, MIX, WS_MIX); WSP(bf16, WOUT, WS_WOUT); WSP(bf16, XW, WS_XW); WSP(float, MODV, WS_MODV);
            pg8::Gemm g{MIX, WOUT + (size_t)l * 1024 * 1024, MROWS, 1024, 1024}; pg8::StaticOrder S; S.init(MROWS, 1024, G, bid);
            pg8::EpiResid E{inp[I_X], inp[I_CTX], l == 0 ? (const bf16*)nullptr : XW, XW, MODV + (size_t)l * 17 * NMODC};
            pg8::gemm_phase<pg8::EpiResid, pg8::StaticOrder, true, true>(lds, g, S, E, wave0);
        }
        SEAM(pb + 4);

        if (IN(pb + 5)) REPEAT(8) {
            PHASE_VIEW();
            WSP(bf16, XW, WS_XW); WSP(bf16, H, WS_H); WSP(float, MODV, WS_MODV); WSP(int, PAIRE, WS_PAIRE); WSP(int, PAIRR, WS_PAIRR); WSP(float, PAIRG, WS_PAIRG);
            WSP(bf16, RWH, WS_RWH); WSP(bf16, RWL, WS_RWL);
            unsigned* cntw = (unsigned*)(wsb + WS_CTL) + CW_CNT + l * 32 * 64;
            const float* modv = MODV + (size_t)l * 17 * NMODC;
            constexpr int HSP = 1028;
            LAS float* hs = (LAS float*)lds;
            LAS float* part = (LAS float*)(lds + 66048);
            LAS int* lcount = (LAS int*)(lds + 82432);
            LAS int* lbase = (LAS int*)(lds + 82432 + 128);
            LAS int* tke = (LAS int*)(lds + 82688);
            LAS int* tkr = (LAS int*)(lds + 82688 + 10240);
            LAS float* tkg = (LAS float*)(lds + 82688 + 20480);
            const int per = (MROWS + G - 1) / G;
            const int t0 = bid * per, t1 = (t0 + per < MROWS) ? t0 + per : MROWS;
            __syncthreads();
            if (tid < 32) lcount[tid] = 0;
            const float* rb = inp[I_RB] + l * 32;
            const int c = lane & 15, g = lane >> 4;
            const bf16* rwh = RWH + (size_t)l * 32 * 1024; const bf16* rwl = RWL + (size_t)l * 32 * 1024;
            bf16x8_t rah[4][2], ral[4][2];
#pragma unroll
            for (int ks = 0; ks < 4; ++ks)
#pragma unroll
                for (int nb = 0; nb < 2; ++nb) { const size_t o = (size_t)(16 * nb + c) * 1024 + 128 * wave + 32 * ks + 8 * g; rah[ks][nb] = *(const bf16x8_t*)(rwh + o); ral[ks][nb] = *(const bf16x8_t*)(rwl + o); }
            f32x4 nv[2][4];
#define G_LOADROWS(rd_) do { _Pragma("unroll") for (int q = 0; q < 2; ++q) { int row_ = (rd_) + wave * 2 + q; row_ = row_ < t1 ? row_ : t1 - 1; _Pragma("unroll") for (int j = 0; j < 4; ++j) { const v2u w_ = *(const v2u*)(XW + (size_t)row_ * D + j * 256 + lane * 4); nv[q][j] = (f32x4){bflo(w_.x), bfhi(w_.x), bflo(w_.y), bfhi(w_.y)}; } } } while (0)
            G_LOADROWS(t0);
            for (int rd = t0; rd < t1; rd += 16) {
                __syncthreads();
#pragma unroll
                for (int q = 0; q < 2; ++q) {
                    const int tk = wave * 2 + q; const int row = rd + tk;
                    if (row < t1) {
                        const int b = (row < ML) ? row / SEQ : NB; const float* mv = modv + (size_t)b * NMODC;
                        f32x4 v[4]; float ss = 0.f;
#pragma unroll
                        for (int j = 0; j < 4; ++j) { v[j] = nv[q][j]; ss += (v[j].x * v[j].x + v[j].y * v[j].y) + (v[j].z * v[j].z + v[j].w * v[j].w); }
                        const float rstd = rsqrtf(wave_sum(ss) * (1.f / D) + EPS);
#pragma unroll
                        for (int j = 0; j < 4; ++j) { const int idx = j * 256 + lane * 4;
                            const f32x4 gn = *(const f32x4*)(inp[I_NORM2] + l * D + idx), sh = *(const f32x4*)(mv + 3 * D + idx), sc = *(const f32x4*)(mv + 4 * D + idx);
                            const f32x4 y = v[j] * rstd * gn * (sc + 1.f) + sh;
                            v2u o; o.x = pk2(y.x, y.y); o.y = pk2(y.z, y.w); *(v2u*)(H + (size_t)row * D + idx) = o;
                            *(LAS f32x4*)(hs + tk * HSP + idx) = y; }
                    } else { float z0 = 0.f; asm volatile("" : "+v"(z0));
#pragma unroll
                        for (int j = 0; j < 4; ++j) *(LAS f32x4*)(hs + tk * HSP + j * 256 + lane * 4) = (f32x4){z0, z0, z0, z0};
                    }
                }
                __syncthreads();
                if (rd + 16 < t1) G_LOADROWS(rd + 16);
                {
                    f32x4 acc[2] = {(f32x4){0.f, 0.f, 0.f, 0.f}, (f32x4){0.f, 0.f, 0.f, 0.f}};
#pragma unroll
                    for (int ks = 0; ks < 4; ++ks) { const int k0 = 128 * wave + 32 * ks + 8 * g;
                        const f32x4 h0 = *(const LAS f32x4*)(hs + c * HSP + k0), h1 = *(const LAS f32x4*)(hs + c * HSP + k0 + 4);
                        const float hv[8] = {h0.x, h0.y, h0.z, h0.w, h1.x, h1.y, h1.z, h1.w};
                        v4u whi, wlo; unsigned* ph = (unsigned*)&whi; unsigned* pl = (unsigned*)&wlo;
#pragma unroll
                        for (int j = 0; j < 8; j += 2) { const unsigned a = f2bf(hv[j]), b2 = f2bf(hv[j + 1]);
                            ph[j >> 1] = a | (b2 << 16);
                            pl[j >> 1] = pk2(hv[j] - __builtin_bit_cast(float, a << 16), hv[j + 1] - __builtin_bit_cast(float, b2 << 16)); }
                        const bf16x8_t bh = __builtin_bit_cast(bf16x8_t, whi), bl = __builtin_bit_cast(bf16x8_t, wlo);
#pragma unroll
                        for (int nb = 0; nb < 2; ++nb) { const bf16x8_t ah = rah[ks][nb], al = ral[ks][nb];
                            acc[nb] = __builtin_amdgcn_mfma_f32_16x16x32_bf16(ah, bh, acc[nb], 0, 0, 0);
                            acc[nb] = __builtin_amdgcn_mfma_f32_16x16x32_bf16(al, bh, acc[nb], 0, 0, 0);
                            acc[nb] = __builtin_amdgcn_mfma_f32_16x16x32_bf16(ah, bl, acc[nb], 0, 0, 0); } }
#pragma unroll
                    for (int nb = 0; nb < 2; ++nb) *(LAS f32x4*)(part + (wave * 16 + c) * 32 + 16 * nb + 4 * g) = acc[nb];
                }
                __syncthreads();
                {
                    const int tk = tid >> 5, e = tid & 31; const int row = rd + tk;
                    float lg = rb[e];
#pragma unroll
                    for (int w = 0; w < 8; ++w) lg += part[(w * 16 + tk) * 32 + e];
                    float vv = lg; int se[4]; float sl[4];
#pragma unroll
                    for (int kk = 0; kk < 4; ++kk) { float mx = vv;
#pragma unroll
                        for (int off = 16; off >= 1; off >>= 1) mx = fmaxf(mx, __shfl_xor(mx, off));
                        const unsigned long long bal = __ballot(vv == mx); const int ee = __ffs((unsigned)(bal >> (lane & 32))) - 1;
                        se[kk] = ee; sl[kk] = mx; if (e == ee) vv = -INFINITY; }
                    const float p1 = __expf(sl[1] - sl[0]), p2 = __expf(sl[2] - sl[0]), p3 = __expf(sl[3] - sl[0]); const float inv = 1.f / (1.f + p1 + p2 + p3);
                    if (e < 4 && row < t1) { const int ee = e == 0 ? se[0] : e == 1 ? se[1] : e == 2 ? se[2] : se[3];
                        const float gg = (e == 0 ? 1.f : e == 1 ? p1 : e == 2 ? p2 : p3) * inv;
                        const int lr = __hip_atomic_fetch_add(lcount + ee, 1, __ATOMIC_RELAXED, __HIP_MEMORY_SCOPE_WORKGROUP);
                        const int ti = row - t0; tke[ti * 4 + e] = ee; tkr[ti * 4 + e] = lr; tkg[ti * 4 + e] = gg; }
                }
            }
            __syncthreads();
#undef G_LOADROWS
            if (rep_ + 1 < nrep_) continue;
            if (tid < 32) lbase[tid] = (int)__hip_atomic_fetch_add(cntw + tid * 64, (unsigned)lcount[tid], __ATOMIC_RELAXED, __HIP_MEMORY_SCOPE_AGENT);
            __syncthreads();
            { WSP(int, TOKE, WS_TOKE); WSP(float, GATEE, WS_GATEE);
              for (int i = tid; i < (t1 - t0) * 4; i += NTHR) { const int ee = tke[i], rk = lbase[ee] + tkr[i]; PAIRE[(size_t)t0 * 4 + i] = ee; PAIRR[(size_t)t0 * 4 + i] = rk;
                  TOKE[(size_t)ee * MT + rk] = t0 + (i >> 2); GATEE[(size_t)ee * MT + rk] = tkg[i]; } }
        }
        SEAM(pb + 5);

        LAS int* tstart = (LAS int*)(lds + TAB_OFF);
        if (IN(pb + 6) || IN(pb + 7) || IN(pb + 8)) {
            PHASE_VIEW(); unsigned* cntw = (unsigned*)(wsb + WS_CTL) + CW_CNT + l * 32 * 64;
            __syncthreads();
            if (tid == 0) { int acc = 0; for (int e2 = 0; e2 < NE; ++e2) { tstart[e2] = acc; const unsigned c = __hip_atomic_load(cntw + e2 * 64, __ATOMIC_RELAXED, __HIP_MEMORY_SCOPE_AGENT); tstart[33 + e2] = (int)c; acc += (int)((c + 255u) >> 8); } tstart[NE] = acc; }
            __syncthreads();
        }
        if (IN(pb + 6)) REPEAT(10) {
            PHASE_VIEW();
            WSP(bf16, H, WS_H); WSP(bf16, WGU, WS_WGU); WSP(bf16, ACT, WS_ACT); WSP(float, BGU, WS_BGU); WSP(int, TOK, WS_TOKE);
            pg8::Gemm g{H, WGU + (size_t)l * 32 * 2048 * 1024, 0, 0, 1024}; LAS unsigned short* rtab = (LAS unsigned short*)(lds + TAB_OFF + 512);
            pg8::MoeOrderT<true> S{tstart, tstart[NE], 8, G, bid, TOK, rtab}; S.preload(rtab, tid); __syncthreads();
            pg8::EpiSwiglu E{ACT, BGU + (size_t)l * 32 * 2048};
            pg8::gemm_phase<pg8::EpiSwiglu, pg8::MoeOrderT<true>, true, true>(lds, g, S, E, wave0, 1 + ((rep_mask >> 22) & 1));
        }
        SEAM(pb + 6);

        if (IN(pb + 7)) REPEAT(11) {
            PHASE_VIEW();
            WSP(bf16, ACT, WS_ACT); WSP(bf16, WDN, WS_WDN); WSP(bf16, Y, WS_Y); WSP(float, SLOTG, WS_GATEE);
            pg8::Gemm g{ACT, WDN + (size_t)l * 32 * 1024 * 1024, 0, 0, 1024}; pg8::MoeOrderT<false> S{tstart, tstart[NE], 4, G, bid, nullptr, nullptr};
            pg8::EpiDown E{Y, inp[I_BDN] + (size_t)l * 32 * 1024, SLOTG, tstart};
            pg8::gemm_phase<pg8::EpiDown, pg8::MoeOrderT<false>, true, true>(lds, g, S, E, wave0, 1 + ((rep_mask >> 22) & 1));
        }
        SEAM(pb + 7);

        if (IN(pb + 8)) for (int rep_ = 0, nrep_ = 1 + ((rep_mask >> 12) & l & 1); rep_ < nrep_; ++rep_) {
            PHASE_VIEW();
            WSP(bf16, XW, WS_XW); WSP(bf16, H, WS_H); WSP(bf16, Y, WS_Y); WSP(float, MODV, WS_MODV); WSP(int, PAIRE, WS_PAIRE); WSP(int, PAIRR, WS_PAIRR);
            for (int row = gw; row < MROWS; row += NGW) {
                const int b = (row < ML) ? row / SEQ : NB; const float* mv = MODV + ((size_t)l * 17 + b) * NMODC;
                f32x4 y[4];
#pragma unroll
                for (int j = 0; j < 4; ++j) y[j] = (f32x4){0.f, 0.f, 0.f, 0.f};
#pragma unroll
                for (int k = 0; k < 4; ++k) { const int slot = tstart[PAIRE[(size_t)row * 4 + k]] * 256 + PAIRR[(size_t)row * 4 + k];
#pragma unroll
                    for (int j = 0; j < 4; ++j) { const v2u w = *(const v2u*)(Y + (size_t)slot * D + j * 256 + lane * 4);
                        y[j].x += bflo(w.x); y[j].y += bfhi(w.x); y[j].z += bflo(w.y); y[j].w += bfhi(w.y); } }
                f32x4 v[4];
#pragma unroll
                for (int j = 0; j < 4; ++j) { const int idx = j * 256 + lane * 4; const f32x4 g5 = *(const f32x4*)(mv + 5 * D + idx);
                    const v2u xw = *(const v2u*)(XW + (size_t)row * D + idx); v[j] = (f32x4){bflo(xw.x), bfhi(xw.x), bflo(xw.y), bfhi(xw.y)} + g5 * y[j]; }
                if (l == 0) {
#pragma unroll
                    for (int j = 0; j < 4; ++j) { v2u o; o.x = pk2(v[j].x, v[j].y); o.y = pk2(v[j].z, v[j].w); *(v2u*)(XW + (size_t)row * D + j * 256 + lane * 4) = o; }
                    const float* mv1 = MODV + (size_t)(17 + b) * NMODC;
                    norm_mod_row(v, inp[I_NORM1] + D, mv1 + 0 * D, mv1 + 1 * D, H + (size_t)row * D, lane);
                } else {
#pragma unroll
                    for (int j = 0; j < 4; ++j) *(f32x4*)((*(float* const CAS*)(kap + offsetof(Args, out))) + (size_t)row * D + j * 256 + lane * 4) = v[j];
                }
            }
        }
        SEAM(pb + 8);
    }
#undef IN
#undef SEAM
}

extern "C" void kernel_launch(void* const* d_in, const int* in_sizes, int n_in, void* d_out, int out_size, void* d_ws, size_t ws_size, hipStream_t stream) {
    static int grid = 0;
    if (grid == 0) {
        if (n_in != 29 || out_size != ML * D || ws_size < WS_END) { fprintf(stderr, "kernel_launch: unexpected shapes (n_in %d, out %d, ws %zu < %zu)\n", n_in, out_size, ws_size, (size_t)WS_END); grid = -1; return; }
        int dev = 0, cus = 0, per_cu = 0;
        if (hipGetDevice(&dev) != hipSuccess || hipDeviceGetAttribute(&cus, hipDeviceAttributeMultiprocessorCount, dev) != hipSuccess) { grid = -1; return; }
        if (hipFuncSetAttribute((const void*)fwd, hipFuncAttributeMaxDynamicSharedMemorySize, LDS_BYTES) != hipSuccess) { fprintf(stderr, "kernel_launch: hipFuncSetAttribute failed\n"); grid = -1; return; }
        if (hipOccupancyMaxActiveBlocksPerMultiprocessor(&per_cu, (const void*)fwd, NTHR, LDS_BYTES) != hipSuccess || per_cu < 1) fprintf(stderr, "kernel_launch: occupancy query says %d\n", per_cu);
        (void)hipGetLastError();
        grid = cus > 256 ? 256 : cus;
        if (grid < 224 || (grid & 7)) { fprintf(stderr, "kernel_launch: this build needs a 224..256-CU device (multiple of 8), got %d\n", cus); grid = -1; return; }
    }
    if (grid < 0) return;
    (void)hipMemsetAsync((char*)d_ws + WS_CTL, 0, CTL_ZERO_BYTES, stream);
    Args a{};
    for (int i = 0; i < 29; ++i) a.in[i] = (const float*)d_in[i];
    a.out = (float*)d_out; a.ws = (unsigned char*)d_ws; a.rep_mask = PROBE_REP; a.pad = 0;
    constexpr int NPH = 20;
#if MK_PER_PHASE
    for (int p = 0; p < NPH; ++p) { a.ph_lo = p; a.ph_hi = p + 1; hipLaunchKernelGGL(fwd, dim3(grid), dim3(NTHR), LDS_BYTES, stream, a); }
#else
    a.ph_lo = 0; a.ph_hi = NPH; hipLaunchKernelGGL(fwd, dim3(grid), dim3(NTHR), LDS_BYTES, stream, a);
#endif
}
```

```cpp
#include <hip/hip_runtime.h>
#include <cstdio>
#include <cstdint>
#include <cstddef>
#include <type_traits>
#ifndef MK_PER_PHASE
#define MK_PER_PHASE 0
#endif
namespace pg8 {
#define PG8_LAS __attribute__((address_space(3)))
typedef unsigned short bf16_t;
typedef short bf16x8 __attribute__((ext_vector_type(8)));
typedef float f32x4 __attribute__((ext_vector_type(4)));
typedef unsigned u32x4 __attribute__((ext_vector_type(4)));
constexpr int BM = 256, BK = 64, HALF = 128, HTB = HALF * BK * 2  , STAGE_BYTES = 8 * HTB, NXCD = 8, WGM = 8;

__host__ __device__ __forceinline__ int lds_byte(int r, int c) { const int f = r & 7; return (r >> 3) * 1024 + f * 128 + ((((c >> 3) ^ f) & 7) << 4) + (c & 7) * 2; }
__host__ __device__ __forceinline__ void stage_rc(int b, int& R, int& C) { const int pc = b / 1024, wb = b % 1024, f = wb >> 7, sc = (wb >> 4) & 7; R = pc * 8 + f; C = ((sc ^ f) << 3) + ((wb & 15) >> 1); }
__host__ __device__ __forceinline__ int perm32(int rho) { const int n = rho >> 4, i = rho & 15; return 8 * (i >> 2) + 4 * n + (i & 3); }

struct Unit { int pm, pn; };
struct Gemm { const bf16_t* A; const bf16_t* Bt; int M, N, K; };

struct StaticOrder {
    static constexpr bool GATHER = false;
    int nM, nN, nwg, G, c;
    __host__ __device__ void init(int M, int N, int G_, int c_) { nM = M / BM; nN = N / BM; nwg = nM * nN; G = G_; c = c_; }
    __host__ __device__ bool next(int i, Unit& u) const {
        const long L = (long)i * G + c; if (L >= nwg) return false;
        int wgid = (int)L; { const int q = nwg / NXCD, r = nwg % NXCD, xcd = wgid % NXCD, off = wgid / NXCD; wgid = (xcd < r ? xcd * (q + 1) : r * (q + 1) + (xcd - r) * q) + off; }
        const int nig = WGM * nN, gid = wgid / nig, fm = gid * WGM, gsz = (nM - fm) < WGM ? (nM - fm) : WGM;
        u.pm = fm + ((wgid % nig) % gsz); u.pn = (wgid % nig) / gsz; return true;
    }
    __device__ __forceinline__ void a_ready(const Unit&) const {}
    __device__ __forceinline__ void done(const Unit&) const {}
};

__device__ __forceinline__ unsigned cvt_pk_bf16(float lo, float hi) { unsigned r; asm volatile("v_cvt_pk_bf16_f32 %0, %1, %2" : "=v"(r) : "v"(lo), "v"(hi)); return r; }
typedef float f32x2 __attribute__((ext_vector_type(2)));
template <class Epi, class Sched, bool ALIGN_EPI = false, bool SP2 = false>
__device__ __forceinline__ void gemm_phase(PG8_LAS unsigned char* lds, const Gemm g, const Sched& S, const Epi& E, const int wave_s  , const int epi_reps = 1) {
    unsigned ones_ = ~0u; asm volatile("" : "+s"(ones_));
    int tid_raw = wave_s * 64 + (int)__builtin_amdgcn_mbcnt_hi(ones_, __builtin_amdgcn_mbcnt_lo(ones_, 0u)); asm volatile("" : "+v"(tid_raw));
    const int tid = tid_raw, wid = __builtin_amdgcn_readfirstlane(tid >> 6), lane = tid & 63, wr = wid >> 2, wc = wid & 3, fr = lane & 15, fq = lane >> 4;
    const int K = g.K, nt = K / BK;
    unsigned voffA[2], voffB[2];
#pragma unroll
    for (int i = 0; i < 2; ++i) { int R, C; stage_rc(tid * 16 + i * 8192, R, C); const int Rb = Epi::PERM ? ((R & ~31) + perm32(R & 31)) : R;
        voffA[i] = (unsigned)(R * K + C) * 2u; voffB[i] = (unsigned)(Rb * K + C) * 2u; }
    unsigned gA[2][2], gAn[2][2];
    const size_t kstep = (size_t)(BK * 2);
    const size_t hstep = (size_t)HALF * K * 2;
    const size_t tstep = 2 * hstep;
    const unsigned ldsw = (unsigned)wid * 1024u;
    const int aoff = lds_byte(wr * 64 + fr, fq * 8), boff = lds_byte(wc * 32 + fr, fq * 8);
#define PG8_SA(b, h) (((b) * 2 + (h)) * HTB)
#define PG8_SB(b, h) ((4 + (b) * 2 + (h)) * HTB)
#define PG8_STAGE(bufoff, gbase, voff) do { _Pragma("unroll") for (int _i = 0; _i < 2; ++_i) \
        __builtin_amdgcn_global_load_lds((const unsigned*)((const char*)(gbase) + (voff)[_i]), (PG8_LAS unsigned*)(lds + (bufoff) + ldsw + _i * 8192), 16, 0, 0); } while (0)
#define PG8_STAGE_A(bufoff, base, h, nx) do { if constexpr (Sched::GATHER) { _Pragma("unroll") for (int _i = 0; _i < 2; ++_i) \
        __builtin_amdgcn_global_load_lds((const unsigned*)((const char*)(base) + ((nx) ? gAn[h][_i] : gA[h][_i])), (PG8_LAS unsigned*)(lds + (bufoff) + ldsw + _i * 8192), 16, 0, 0); } \
    else { PG8_STAGE(bufoff, (base) + (h) * hstep, voffA); } } while (0)
#define PG8_LDA(dst, b, h) do { _Pragma("unroll") for (int m = 0; m < 4; ++m) _Pragma("unroll") for (int k = 0; k < 2; ++k) dst[m][k] = *(const PG8_LAS bf16x8*)(lds + PG8_SA(b, h) + (aoff ^ (k * 64)) + m * 2048); } while (0)
#define PG8_LDB(dst, b, h) do { _Pragma("unroll") for (int n = 0; n < 2; ++n) _Pragma("unroll") for (int k = 0; k < 2; ++k) dst[n][k] = *(const PG8_LAS bf16x8*)(lds + PG8_SB(b, h) + (boff ^ (k * 64)) + n * 2048); } while (0)
#define PG8_MMA(ai, bj, At, Bt) do { __builtin_amdgcn_s_setprio(1); _Pragma("unroll") for (int m = 0; m < 4; ++m) _Pragma("unroll") for (int n = 0; n < 2; ++n) _Pragma("unroll") for (int k = 0; k < 2; ++k) \
        acc[ai][bj][m][n] = __builtin_amdgcn_mfma_f32_16x16x32_bf16(Bt[n][k], At[m][k], acc[ai][bj][m][n], 0, 0, 0); __builtin_amdgcn_s_setprio(0); } while (0)
#define PG8_WAIT_V(n) asm volatile("s_waitcnt vmcnt(" #n ")" ::: "memory")
#define PG8_WAIT_L(n) asm volatile("s_waitcnt lgkmcnt(" #n ")" ::: "memory")
#define PG8_BAR __builtin_amdgcn_s_barrier()
#define PG8_SCHED __builtin_amdgcn_sched_barrier(0)
    Unit cur, nxt; int ui = 0;
    if (!S.next(0, cur)) return;
    f32x4 acc[2][2][4][2];
#pragma unroll
    for (int a = 0; a < 2; ++a)
#pragma unroll
        for (int b = 0; b < 2; ++b)
#pragma unroll
            for (int m = 0; m < 4; ++m)
#pragma unroll
                for (int n = 0; n < 2; ++n) acc[a][b][m][n] = (f32x4){0.f, 0.f, 0.f, 0.f};
    bf16x8 At[4][2], B0[2][2], B1[2][2];
    const char* cA = (const char*)g.A + (Sched::GATHER ? (size_t)0 : (size_t)cur.pm * tstep); const char* cB = (const char*)g.Bt + (size_t)cur.pn * tstep;
    S.a_ready(cur);
    if constexpr (Sched::GATHER) { S.rows(cur, 0, tid, K, gA);
#pragma unroll
        for (int h = 0; h < 2; ++h)
#pragma unroll
            for (int i = 0; i < 2; ++i) gAn[h][i] = gA[h][i]; }
    if constexpr (SP2) {
        PG8_STAGE(PG8_SB(0, 0), cB, voffB); PG8_STAGE(PG8_SB(0, 1), cB + hstep, voffB); PG8_STAGE_A(PG8_SA(0, 0), cA, 0, false); PG8_STAGE_A(PG8_SA(0, 1), cA, 1, false);
        if (wr == 1) PG8_BAR;
        PG8_WAIT_V(2); PG8_BAR;
        PG8_STAGE(PG8_SB(1, 0), cB + kstep, voffB); PG8_STAGE_A(PG8_SA(1, 0), cA + kstep, 0, false); PG8_STAGE(PG8_SB(1, 1), cB + hstep + kstep, voffB);
        PG8_WAIT_V(6); PG8_BAR;
    } else {
        PG8_STAGE(PG8_SB(0, 0), cB, voffB); PG8_STAGE_A(PG8_SA(0, 0), cA, 0, false); PG8_STAGE(PG8_SB(0, 1), cB + hstep, voffB); PG8_STAGE_A(PG8_SA(0, 1), cA, 1, false);
        if (wr == 1) PG8_BAR;
        PG8_WAIT_V(4); PG8_BAR;
        PG8_STAGE(PG8_SB(1, 0), cB + kstep, voffB); PG8_STAGE_A(PG8_SA(1, 0), cA + kstep, 0, false); PG8_STAGE(PG8_SB(1, 1), cB + hstep + kstep, voffB);
        PG8_WAIT_V(6); PG8_BAR;
    }
    for (;;) {
        const bool has_next = S.next(ui + 1, nxt);
        const char* nA = (has_next && !Sched::GATHER) ? (const char*)g.A + (size_t)nxt.pm * tstep : cA; const char* nB = has_next ? (const char*)g.Bt + (size_t)nxt.pn * tstep : cB;
        if constexpr (Sched::GATHER) { if (has_next) S.rows(nxt, ui + 1, tid, K, gAn); }
        if constexpr (Epi::LDS_BIAS) E.prefetch(cur, ui & 1, lds, wid, lane);
        for (int t = 0; t < nt; t += 2) {
            const bool last = (t == nt - 2);
            const char* a1 = cA + (size_t)(t + 1) * kstep;
            const char* a2 = last ? nA : cA + (size_t)(t + 2) * kstep; const char* b2 = last ? nB : cB + (size_t)(t + 2) * kstep;
            const char* a3 = a2 + kstep; const char* b3 = b2 + kstep;
            if (last && has_next) S.a_ready(nxt);
            if constexpr (SP2) {
            PG8_LDB(B0, 0, 0); PG8_LDB(B1, 0, 1); PG8_SCHED; PG8_LDA(At, 0, 0); PG8_STAGE_A(PG8_SA(1, 1), a1, 1, false);
            PG8_WAIT_V(8); PG8_WAIT_L(0); PG8_BAR; PG8_MMA(0, 0, At, B0); PG8_MMA(0, 1, At, B1); PG8_BAR; PG8_SCHED;
            PG8_LDA(At, 0, 1); PG8_STAGE(PG8_SB(0, 0), b2, voffB); PG8_STAGE(PG8_SB(0, 1), b2 + hstep, voffB); PG8_STAGE_A(PG8_SA(0, 0), a2, 0, last);
            PG8_WAIT_V(8); PG8_WAIT_L(0); PG8_BAR; PG8_MMA(1, 0, At, B0); PG8_MMA(1, 1, At, B1); PG8_BAR; PG8_SCHED;
            PG8_LDB(B0, 1, 0); PG8_LDB(B1, 1, 1); PG8_SCHED; PG8_LDA(At, 1, 0); PG8_STAGE_A(PG8_SA(0, 1), a2, 1, last);
            PG8_WAIT_V(8); PG8_WAIT_L(0); PG8_BAR; PG8_MMA(0, 0, At, B0); PG8_MMA(0, 1, At, B1); PG8_BAR; PG8_SCHED;
            PG8_LDA(At, 1, 1); PG8_STAGE(PG8_SB(1, 0), b3, voffB); PG8_STAGE(PG8_SB(1, 1), b3 + hstep, voffB); PG8_STAGE_A(PG8_SA(1, 0), a3, 0, last);
            PG8_WAIT_V(8); PG8_WAIT_L(0); PG8_BAR; PG8_MMA(1, 0, At, B0); PG8_MMA(1, 1, At, B1); PG8_BAR; PG8_SCHED;
            } else {
            PG8_LDB(B0, 0, 0); PG8_SCHED; PG8_LDA(At, 0, 0); PG8_STAGE_A(PG8_SA(1, 1), a1, 1, false);
            PG8_WAIT_L(8); PG8_BAR; PG8_WAIT_L(0); PG8_MMA(0, 0, At, B0); PG8_BAR; PG8_SCHED;
            PG8_LDB(B1, 0, 1); PG8_STAGE(PG8_SB(0, 0), b2, voffB);
            PG8_BAR; PG8_WAIT_L(0); PG8_MMA(0, 1, At, B1); PG8_BAR;
            PG8_LDA(At, 0, 1); PG8_STAGE_A(PG8_SA(0, 0), a2, 0, last);
            PG8_BAR; PG8_WAIT_L(0); PG8_MMA(1, 0, At, B0); PG8_BAR; PG8_SCHED;
            PG8_STAGE(PG8_SB(0, 1), b2 + hstep, voffB);
            PG8_WAIT_V(6); PG8_BAR; PG8_MMA(1, 1, At, B1); PG8_BAR;
            PG8_LDB(B0, 1, 0); PG8_SCHED; PG8_LDA(At, 1, 0); PG8_STAGE_A(PG8_SA(0, 1), a2, 1, last);
            PG8_WAIT_L(8); PG8_BAR; PG8_WAIT_L(0); PG8_MMA(0, 0, At, B0); PG8_BAR; PG8_SCHED;
            PG8_LDB(B1, 1, 1); PG8_STAGE(PG8_SB(1, 0), b3, voffB);
            PG8_BAR; PG8_WAIT_L(0); PG8_MMA(0, 1, At, B1); PG8_BAR;
            PG8_LDA(At, 1, 1); PG8_STAGE_A(PG8_SA(1, 0), a3, 0, last);
            PG8_BAR; PG8_WAIT_L(0); PG8_MMA(1, 0, At, B0); PG8_BAR; PG8_SCHED;
            PG8_STAGE(PG8_SB(1, 1), b3 + hstep, voffB);
            PG8_WAIT_V(6); PG8_BAR; PG8_MMA(1, 1, At, B1); PG8_BAR;
            }
        }
        if constexpr (ALIGN_EPI) { if (wr == 0) PG8_BAR; }
        if constexpr (!Epi::AFTER_DRAIN) { if constexpr (Epi::LDS_BIAS) E(acc, cur, wr, wc, fr, fq, lds, ui & 1); else E(acc, cur, wr, wc, fr, fq); S.done(cur); }
        if (!has_next) break;
#pragma unroll
        for (int a = 0; a < 2; ++a)
#pragma unroll
            for (int b = 0; b < 2; ++b)
#pragma unroll
                for (int m = 0; m < 4; ++m)
#pragma unroll
                    for (int n = 0; n < 2; ++n) acc[a][b][m][n] = (f32x4){0.f, 0.f, 0.f, 0.f};
        cur = nxt; cA = nA; cB = nB; ++ui;
        if constexpr (Sched::GATHER) {
#pragma unroll
            for (int h = 0; h < 2; ++h)
#pragma unroll
                for (int i = 0; i < 2; ++i) gA[h][i] = gAn[h][i]; }
        if constexpr (ALIGN_EPI) { if (wr == 1) PG8_BAR; }
    }
    PG8_WAIT_V(0);
    if constexpr (!ALIGN_EPI) { if (wr == 0) PG8_BAR; }
    PG8_BAR;
    if constexpr (Epi::AFTER_DRAIN) { E.fused(acc, cur, wr, wc, fr, fq, lds, wid, lane); S.done(cur); }
#undef PG8_SA
#undef PG8_SB
#undef PG8_STAGE
#undef PG8_STAGE_A
#undef PG8_LDA
#undef PG8_LDB
#undef PG8_MMA
#undef PG8_WAIT_V
#undef PG8_WAIT_L
#undef PG8_BAR
#undef PG8_SCHED
}
}

constexpr int D = 1024, NB = 16, SEQ = 2048, CL = 256, ML = NB * SEQ, MC = NB * CL, MT = ML + MC;
constexpr int NIN = 2992, NINP = 3072, NE = 32, NMODC = 6 * D;
constexpr int PC_AQ = 0, PC_AK = 256, PC_AV = 384, PC_GQ = 512, PC_GZ = 2048, PC_GA = 2560, PC_GB = 2568, PC_CQ = 2576, PC_CKV = 2832, PC_CKR = 2960;
constexpr float EPS = 1e-6f;
constexpr int NSLOT = (MT * 4 / 256 + NE) * 256;
constexpr int NWAVES = 8, NTHR = 512;

constexpr size_t MiB = 1u << 20;
constexpr size_t WS_CTL = 0, CTL_ZERO_BYTES = 1 * MiB;
constexpr size_t WS_MODV = 1 * MiB;
constexpr size_t WS_BGU = 2 * MiB;
constexpr size_t WS_PAIRE = 3 * MiB;
constexpr size_t WS_PAIRR = 4 * MiB;
constexpr size_t WS_PAIRG = 5 * MiB;
constexpr size_t WS_SLOTG = 6 * MiB;
constexpr size_t WS_RWH = 7 * MiB;
constexpr size_t WS_RWL = 7 * MiB + 262144;
constexpr size_t WS_WIN = 8 * MiB;
constexpr size_t WS_WOUT = 20 * MiB;
constexpr size_t WS_WGU = 24 * MiB;
constexpr size_t WS_WDN = 280 * MiB;
constexpr size_t WS_XW = 408 * MiB;
constexpr size_t WS_H = 552 * MiB;
constexpr size_t WS_MIX = 624 * MiB;
constexpr size_t WS_BIG = 696 * MiB;
constexpr size_t WS_P = WS_BIG;
constexpr size_t WS_QA = WS_BIG + 217 * MiB;
constexpr size_t WS_KA = WS_BIG + 253 * MiB;
constexpr size_t WS_VA = WS_BIG + 271 * MiB;
constexpr size_t WS_QM = WS_BIG + 289 * MiB;
constexpr size_t WS_KM = WS_BIG + 343 * MiB;
constexpr size_t WS_VM = WS_BIG + 397 * MiB;
constexpr size_t WS_GW = WS_BIG + 433 * MiB;
constexpr size_t WS_GQD = WS_BIG + 505 * MiB;
constexpr size_t WS_GKDT = WS_BIG + 577 * MiB;
constexpr size_t WS_GQKM = WS_BIG + 649 * MiB;
constexpr size_t WS_GUT = WS_BIG + 685 * MiB;
constexpr size_t WS_GGE = WS_BIG + 829 * MiB;
constexpr size_t WS_OD = WS_BIG + 830 * MiB;
constexpr size_t WS_XS = WS_BIG;
constexpr size_t WS_ACT = WS_BIG + 304 * MiB;
constexpr size_t WS_Y = WS_BIG + 608 * MiB;
constexpr size_t WS_PAIRS = WS_BIG + 974 * MiB;
constexpr size_t WS_TOK = WS_BIG + 975 * MiB;
constexpr size_t WS_TOKE = WS_BIG + 976 * MiB;
constexpr size_t WS_GATEE = WS_BIG + 981 * MiB;
constexpr size_t WS_WUQF = WS_BIG + 986 * MiB;
constexpr size_t WS_WUKVF = WS_BIG + 987 * MiB;
constexpr size_t WS_END = WS_BIG + 988 * MiB;
static_assert((size_t)NSLOT * 2048 <= 304 * MiB && (size_t)MT * 3072 * 2 + 8192 <= 217 * MiB, "ws map");
constexpr int CW_BAR = 4096;
constexpr int CW_CNT = 16384;
constexpr int CW_AQ = 12288;

constexpr int RING_BYTES = 131072, TAB_OFF = RING_BYTES, LDS_BYTES = 155648;
constexpr int MISC_OFF = LDS_BYTES - 256;

#define LAS __attribute__((address_space(3)))
typedef unsigned short bf16;
typedef unsigned v4u __attribute__((ext_vector_type(4)));
typedef unsigned v2u __attribute__((ext_vector_type(2)));
typedef float f32x4 __attribute__((ext_vector_type(4)));
typedef short bf16x8_t __attribute__((ext_vector_type(8)));
#define LDS_WAIT() asm volatile("s_waitcnt lgkmcnt(0)" ::: "memory")
__device__ __forceinline__ unsigned f2bf(float f) { unsigned u = __builtin_bit_cast(unsigned, f); return (u + 0x7fffu + ((u >> 16) & 1u)) >> 16; }
typedef float f32x2_t __attribute__((ext_vector_type(2)));
typedef __bf16 bf16x2_t __attribute__((ext_vector_type(2)));
__device__ __forceinline__ unsigned pk2(float lo, float hi) { const f32x2_t v = {lo, hi}; const bf16x2_t b = __builtin_convertvector(v, bf16x2_t); return __builtin_bit_cast(unsigned, b); }
__device__ __forceinline__ float bf2f(unsigned short b) { return __builtin_bit_cast(float, ((unsigned)b) << 16); }
__device__ __forceinline__ float bflo(unsigned w) { return __builtin_bit_cast(float, w << 16); }
__device__ __forceinline__ float bfhi(unsigned w) { return __builtin_bit_cast(float, w & 0xffff0000u); }
__device__ __forceinline__ float wave_sum(float v) {
#pragma unroll
    for (int o = 1; o < 64; o <<= 1) v += __shfl_xor(v, o);
    return v;
}
__device__ __forceinline__ float siluf(float x) { return x * __builtin_amdgcn_rcpf(1.f + __expf(-x)); }

#define XB_TMO      128
#define XB_XCNT(j)  (256  + 64 * (j))
#define XB_XSUB(j)  (1280 + 64 * (j))
#define XB_XGEN(j)  (2304 + 64 * (j))
#define XB_TOP      3328
#define XB_TOPGEN   3392
#define XCD_BAR_WORDS 3456
#define XB_SPIN_CAP (1u << 18)
__device__ __forceinline__ unsigned xb_ld(unsigned* p)              { return __hip_atomic_load(p, __ATOMIC_RELAXED, __HIP_MEMORY_SCOPE_AGENT); }
__device__ __forceinline__ unsigned xb_add(unsigned* p, unsigned v) { return __hip_atomic_fetch_add(p, v, __ATOMIC_RELAXED, __HIP_MEMORY_SCOPE_AGENT); }
__device__ __forceinline__ unsigned xb_xcc_id() { return (unsigned)__builtin_amdgcn_s_getreg((3 << 11) | 20) & 0xFu; }
#define XB_SPIN(cond, bar) do { unsigned _sp = 0; while (cond) { __builtin_amdgcn_s_sleep(1); \
    if ((++_sp & 255u) == 0u) { if (xb_ld(&(bar)[XB_TMO])) break; if (_sp > XB_SPIN_CAP) { atomicAdd(&(bar)[XB_TMO], 1u); break; } } } } while (0)
struct XcdBarrier { unsigned* bar; unsigned x; volatile LAS unsigned* st; };
__device__ __forceinline__ XcdBarrier xcd_barrier_post(unsigned* bar, volatile LAS unsigned* st) {
    XcdBarrier b; b.bar = bar; b.x = xb_xcc_id(); b.st = st;
    if (threadIdx.x == 0) (void)xb_add(&bar[XB_XCNT(b.x)], 1u);
    return b;
}
__device__ __forceinline__ void xcd_barrier_complete(unsigned* bar, unsigned x, unsigned& nloc, unsigned& nx) {
    const unsigned G = gridDim.x * gridDim.y * gridDim.z;
    unsigned sum, cnt, mine, sp = 0u;
    for (;;) {
        sum = 0u; cnt = 0u; mine = 0u;
#pragma unroll
        for (unsigned j = 0; j < 16; ++j) { const unsigned c = xb_ld(&bar[XB_XCNT(j)]); sum += c; cnt += (c > 0u) ? 1u : 0u; mine = (j == x) ? c : mine; }
        if (sum == G) break;
        __builtin_amdgcn_s_sleep(1);
        if ((++sp & 255u) == 0u) { if (xb_ld(&bar[XB_TMO])) break; if (sp > XB_SPIN_CAP) { atomicAdd(&bar[XB_TMO], 1u); break; } }
    }
    nloc = mine > 0u ? mine : 1u; nx = cnt > 0u ? cnt : 1u;
}
__device__ __forceinline__ void xcd_barrier(const XcdBarrier& b) {
    asm volatile("s_waitcnt vmcnt(0)" ::: "memory");
    __syncthreads();
    if (threadIdx.x == 0) {
        unsigned* bar = b.bar;
        __builtin_amdgcn_s_waitcnt(0);
        unsigned nloc = b.st[0], nx = b.st[1];
        if (nloc == 0u) { xcd_barrier_complete(bar, b.x, nloc, nx); b.st[0] = nloc; b.st[1] = nx; }
        const unsigned old = xb_add(&bar[XB_XSUB(b.x)], 1u);
        const unsigned gen = old / nloc;
        if (old + 1u == (gen + 1u) * nloc) {
            __builtin_amdgcn_fence(__ATOMIC_RELEASE, "agent");
            asm volatile("s_waitcnt vmcnt(0)" ::: "memory");
            const unsigned og = xb_add(&bar[XB_TOP], 1u);
            const unsigned tg = og / nx;
            if (og + 1u == (tg + 1u) * nx) xb_add(&bar[XB_TOPGEN], 1u);
            else XB_SPIN(xb_ld(&bar[XB_TOPGEN]) == tg, bar);
            __builtin_amdgcn_fence(__ATOMIC_ACQUIRE, "agent");
            xb_add(&bar[XB_XGEN(b.x)], 1u);
            asm volatile("s_waitcnt vmcnt(0)" ::: "memory");
        } else {
            XB_SPIN(xb_ld(&bar[XB_XGEN(b.x)]) == gen, bar);
            __builtin_amdgcn_fence(__ATOMIC_ACQUIRE, "agent");
            asm volatile("s_waitcnt vmcnt(0)" ::: "memory");
        }
    }
    __syncthreads();
}

namespace pg8 {
struct EpiStoreBf16 {
    static constexpr bool PERM = true, AFTER_DRAIN = false, LDS_BIAS = false;
    bf16_t* O; int ldc;
    __device__ __forceinline__ void operator()(const f32x4 (&acc)[2][2][4][2], const Unit& u, int wr, int wc, int fr, int fq) const {
        const int row0 = u.pm * BM + wr * 64 + fr, col0 = u.pn * BM + wc * 32 + 8 * fq;
#pragma unroll
        for (int ai = 0; ai < 2; ++ai)
#pragma unroll
            for (int m = 0; m < 4; ++m) { bf16_t* rowp = O + (size_t)(row0 + ai * HALF + m * 16) * ldc + col0;
#pragma unroll
                for (int bj = 0; bj < 2; ++bj) { const f32x4 v0 = acc[ai][bj][m][0], v1 = acc[ai][bj][m][1];
                    u32x4 w; w.x = cvt_pk_bf16(v0[0], v0[1]); w.y = cvt_pk_bf16(v0[2], v0[3]); w.z = cvt_pk_bf16(v1[0], v1[1]); w.w = cvt_pk_bf16(v1[2], v1[3]);
                    *(u32x4*)(rowp + bj * HALF) = w; } }
    }
};
struct EpiResid {
    static constexpr bool PERM = false, AFTER_DRAIN = false, LDS_BIAS = false;
    const float* xlat; const float* xctx; const bf16_t* xb; bf16_t* out; const float* modv;
    __device__ __forceinline__ void operator()(const f32x4 (&acc)[2][2][4][2], const Unit& u, int wr, int wc, int fr, int fq) const {
        const int row0 = u.pm * BM + wr * 64 + fr, col0 = u.pn * BM + wc * 32 + 4 * fq;
        const int b = (u.pm < ML / BM) ? (u.pm / (SEQ / BM)) : NB;
        const float* g = modv + (size_t)b * NMODC + 2 * D + col0;
        const float* xin = (u.pm < ML / BM) ? xlat : (xctx - (size_t)ML * D);
        f32x4 gv[2][2];
#pragma unroll
        for (int bj = 0; bj < 2; ++bj)
#pragma unroll
            for (int n = 0; n < 2; ++n) gv[bj][n] = *(const f32x4*)(g + bj * HALF + n * 16);
        typedef unsigned u32x2_ __attribute__((ext_vector_type(2)));
        if (xb) {
#pragma unroll
            for (int ai = 0; ai < 2; ++ai)
#pragma unroll
                for (int m = 0; m < 4; ++m) { const size_t off = (size_t)(row0 + ai * HALF + m * 16) * D + col0;
                    u32x2_ rw[2][2];
#pragma unroll
                    for (int bj = 0; bj < 2; ++bj)
#pragma unroll
                        for (int n = 0; n < 2; ++n) rw[bj][n] = *(const u32x2_*)(xb + off + bj * HALF + n * 16);
#pragma unroll
                    for (int bj = 0; bj < 2; ++bj)
#pragma unroll
                        for (int n = 0; n < 2; ++n) { const unsigned w0 = rw[bj][n].x, w1 = rw[bj][n].y;
                            const f32x4 xi = (f32x4){__builtin_bit_cast(float, w0 << 16), __builtin_bit_cast(float, w0 & 0xffff0000u), __builtin_bit_cast(float, w1 << 16), __builtin_bit_cast(float, w1 & 0xffff0000u)};
                            const f32x4 v = xi + gv[bj][n] * acc[ai][bj][m][n];
                            u32x2_ ow; ow.x = cvt_pk_bf16(v[0], v[1]); ow.y = cvt_pk_bf16(v[2], v[3]);
                            *(u32x2_*)(out + off + bj * HALF + n * 16) = ow; } }
        } else {
#pragma unroll
            for (int ai = 0; ai < 2; ++ai)
#pragma unroll
                for (int m = 0; m < 4; ++m) { const size_t off = (size_t)(row0 + ai * HALF + m * 16) * D + col0;
#pragma unroll
                    for (int bj = 0; bj < 2; ++bj)
#pragma unroll
                        for (int n = 0; n < 2; ++n) { const f32x4 xi = *(const f32x4*)(xin + off + bj * HALF + n * 16);
                            const f32x4 v = xi + gv[bj][n] * acc[ai][bj][m][n];
                            u32x2_ ow; ow.x = cvt_pk_bf16(v[0], v[1]); ow.y = cvt_pk_bf16(v[2], v[3]);
                            *(u32x2_*)(out + off + bj * HALF + n * 16) = ow; } }
        }
    }
};
template <bool GATHER_> struct MoeOrderT {
    static constexpr bool GATHER = GATHER_;
    const LAS int* tstart; int TR, nsub, G, c; const int* tok;
    __device__ __forceinline__ bool next(int i, Unit& u) const {
        int rt, pl;
        if ((G & 7) == 0) { const int x = c & 7, j = c >> 3, bpx = G >> 3; const int r0 = (TR * x) >> 3, r1 = (TR * (x + 1)) >> 3; const int m = i * bpx + j;
            rt = r0 + m / nsub; pl = m % nsub; if (rt >= r1) return false; }
        else { const long L = (long)i * G + c; rt = (int)(L / nsub); pl = (int)(L % nsub); if (rt >= TR) return false; }
        int e = 0, hi = NE;
#pragma unroll
        for (int st = 0; st < 5; ++st) { const int mid = (e + hi) >> 1; const bool le = __builtin_amdgcn_readfirstlane(tstart[mid]) <= rt; e = le ? mid : e; hi = le ? hi : mid; }
        e = __builtin_amdgcn_readfirstlane(e);
        u.pm = rt; u.pn = e * nsub + pl; return true;
    }
    static constexpr int MAXU = 22;
    const LAS unsigned short* ltab;
    __device__ __forceinline__ void preload(LAS unsigned short* tab, int tid) const {
        Unit u;
        for (int ord = 0; ord < MAXU && next(ord, u); ++ord) if (tid < BM) { const int e = u.pn / nsub, rank = (u.pm - tstart[e]) * BM + tid;
            tab[ord * BM + tid] = (rank < tstart[33 + e]) ? (unsigned short)tok[(size_t)e * MT + rank] : (unsigned short)0; }
    }
    __device__ __forceinline__ void rows(const Unit& u, int ord, int tid, int K, unsigned (&out)[2][2]) const {
#pragma unroll
        for (int i = 0; i < 2; ++i) { int R, C; stage_rc(tid * 16 + i * 8192, R, C);
#pragma unroll
            for (int h = 0; h < 2; ++h) out[h][i] = (unsigned)ltab[ord * BM + h * HALF + R] * (unsigned)(K * 2) + (unsigned)C * 2u; }
    }
    __device__ __forceinline__ void a_ready(const Unit&) const {}
    __device__ __forceinline__ void done(const Unit&) const {}
};
constexpr int EBUF_OFF = TAB_OFF + 512 + 22 * 512;
struct EpiSwiglu {
    static constexpr bool PERM = true, AFTER_DRAIN = false, LDS_BIAS = true;
    bf16_t* O; const float* bias;
    __device__ __forceinline__ void prefetch(const Unit& u, int par, PG8_LAS unsigned char* lds, int wid, int lane) const {
        if (wid == 0) __builtin_amdgcn_global_load_lds((const unsigned*)(bias + (size_t)(u.pn >> 3) * 2048 + (u.pn & 7) * 256 + lane * 4), (PG8_LAS unsigned*)(lds + EBUF_OFF + par * 2048), 16, 0, 0);
    }
    __device__ __forceinline__ void operator()(const f32x4 (&acc)[2][2][4][2], const Unit& u, int wr, int wc, int fr, int fq, PG8_LAS unsigned char* lds, int par) const {
        const int pl = u.pn & 7;
        const int row0 = u.pm * BM + wr * 64 + fr, c0 = wc * 32 + 8 * fq;
        const PG8_LAS float* bp = (const PG8_LAS float*)(lds + EBUF_OFF + par * 2048) + c0;
        f32x4 bg[2], bl[2];
#pragma unroll
        for (int n = 0; n < 2; ++n) { bg[n] = *(const PG8_LAS f32x4*)(bp + 4 * n); bl[n] = *(const PG8_LAS f32x4*)(bp + HALF + 4 * n); }
#pragma unroll
        for (int ai = 0; ai < 2; ++ai)
#pragma unroll
            for (int m = 0; m < 4; ++m) { bf16_t* rowp = O + (size_t)(row0 + ai * HALF + m * 16) * 1024 + pl * 128 + c0;
                float r[8];
#pragma unroll
                for (int n = 0; n < 2; ++n)
#pragma unroll
                    for (int j = 0; j < 4; ++j) { const float gl = fminf(acc[ai][0][m][n][j] + bg[n][j], 7.0f);
                        const float li = fminf(fmaxf(acc[ai][1][m][n][j] + bl[n][j], -7.0f), 7.0f);
                        r[n * 4 + j] = gl * __builtin_amdgcn_rcpf(1.f + __expf(-1.702f * gl)) * (li + 1.f); }
                u32x4 w; w.x = cvt_pk_bf16(r[0], r[1]); w.y = cvt_pk_bf16(r[2], r[3]); w.z = cvt_pk_bf16(r[4], r[5]); w.w = cvt_pk_bf16(r[6], r[7]);
                *(u32x4*)rowp = w; }
    }
};
struct EpiDown {
    static constexpr bool PERM = true, AFTER_DRAIN = false, LDS_BIAS = true;
    bf16_t* O; const float* bias; const float* slotg; const PG8_LAS int* tstart;
    __device__ __forceinline__ void prefetch(const Unit& u, int par, PG8_LAS unsigned char* lds, int wid, int lane) const {
        if (wid == 0) __builtin_amdgcn_global_load_lds((const unsigned*)(bias + (size_t)(u.pn >> 2) * 1024 + (u.pn & 3) * 256 + lane * 4), (PG8_LAS unsigned*)(lds + EBUF_OFF + par * 2048), 16, 0, 0);
        if (wid == 1) { const int e = u.pn >> 2; __builtin_amdgcn_global_load_lds((const unsigned*)(slotg + (size_t)e * MT + (size_t)(u.pm - tstart[e]) * BM + lane * 4), (PG8_LAS unsigned*)(lds + EBUF_OFF + par * 2048 + 1024), 16, 0, 0); }
    }
    __device__ __forceinline__ void operator()(const f32x4 (&acc)[2][2][4][2], const Unit& u, int wr, int wc, int fr, int fq, PG8_LAS unsigned char* lds, int par) const {
        const int pl = u.pn & 3;
        const int rl0 = wr * 64 + fr, cl0 = wc * 32 + 8 * fq; const int row0 = u.pm * BM + rl0, col0 = pl * BM + cl0;
        const PG8_LAS float* eb = (const PG8_LAS float*)(lds + EBUF_OFF + par * 2048);
        f32x4 bv[2][2];
#pragma unroll
        for (int bj = 0; bj < 2; ++bj)
#pragma unroll
            for (int n = 0; n < 2; ++n) bv[bj][n] = *(const PG8_LAS f32x4*)(eb + cl0 + bj * HALF + 4 * n);
#pragma unroll
        for (int ai = 0; ai < 2; ++ai)
#pragma unroll
            for (int m = 0; m < 4; ++m) { const int row = row0 + ai * HALF + m * 16; const float gt = eb[256 + rl0 + ai * HALF + m * 16]; bf16_t* rowp = O + (size_t)row * 1024 + col0;
#pragma unroll
                for (int bj = 0; bj < 2; ++bj) { const f32x4 v0 = (acc[ai][bj][m][0] + bv[bj][0]) * gt, v1 = (acc[ai][bj][m][1] + bv[bj][1]) * gt;
                    u32x4 w; w.x = cvt_pk_bf16(v0[0], v0[1]); w.y = cvt_pk_bf16(v0[2], v0[3]); w.z = cvt_pk_bf16(v1[0], v1[1]); w.w = cvt_pk_bf16(v1[2], v1[3]);
                    *(u32x4*)(rowp + bj * HALF) = w; } }
    }
};
}

template <int DQK>
__device__ __forceinline__ void attn_block(LAS unsigned char* lds, const bf16* Qb, int qpitch, const bf16* K, const bf16* Vt, int tA0, int tA1, int tB0, int tB1,
                                           int q0, bool masked, float sc_l2, bool has_sink, float sink_l2, bf16* Ob, int tid) {
    constexpr int NKS = DQK / 32, CPR = DQK / 8  , KP = DQK * 2 + 32  , VP = 160  , KBYTES = 64 * KP, STAGE = KBYTES + 64 * VP;
    const int lane = tid & 63, wv = __builtin_amdgcn_readfirstlane(tid >> 6), r = lane & 15, g = lane >> 4;
    const bf16* Q = Qb + (size_t)(32 * wv) * qpitch; bf16* O = Ob + (size_t)(32 * wv) * D; const int t0 = q0 + 32 * wv;
    bf16x8_t qf[2][NKS];
#pragma unroll
    for (int qb = 0; qb < 2; ++qb)
#pragma unroll
        for (int ks = 0; ks < NKS; ++ks) qf[qb][ks] = *(const bf16x8_t*)(Q + (size_t)(16 * qb + r) * qpitch + 32 * ks + 8 * g);
    f32x4 oacc[2][4];
#pragma unroll
    for (int qb = 0; qb < 2; ++qb)
#pragma unroll
        for (int nb = 0; nb < 4; ++nb) oacc[qb][nb] = (f32x4){0.f, 0.f, 0.f, 0.f};
    float mrun[2] = {-INFINITY, -INFINITY}, lrun[2] = {0.f, 0.f};
    const int kr0 = tid / CPR, kc0 = tid % CPR, kr1 = (tid + 512) / CPR, kc1 = (tid + 512) % CPR, vr = tid >> 3, vc = tid & 7;
    const bool two = (CPR * 64 > 512) && (tid + 512 < CPR * 64);
    v4u sk0, sk1 = (v4u){0u, 0u, 0u, 0u}, sv;
    const unsigned ko0 = (unsigned)(kr0 * DQK + kc0 * 8) * 2u, ko1 = (unsigned)(kr1 * DQK + kc1 * 8) * 2u, vo = (unsigned)(vr * 2304 + vc * 8) * 2u;
#define AB_GLOAD(kt_) do { const char* kb_ = (const char*)K + (size_t)((kt_) * 64) * (DQK * 2); const char* vb_ = (const char*)Vt + (size_t)((kt_) * 64) * 2; \
        sk0 = *(const v4u*)(kb_ + ko0); if (two) sk1 = *(const v4u*)(kb_ + ko1); sv = *(const v4u*)(vb_ + vo); } while (0)
#define AB_LSTORE(buf_) do { LAS unsigned char* sb_ = lds + (buf_) * STAGE; *(LAS v4u*)(sb_ + kr0 * KP + kc0 * 16) = sk0; if (two) *(LAS v4u*)(sb_ + kr1 * KP + kc1 * 16) = sk1; \
        *(LAS v4u*)(sb_ + KBYTES + vr * VP + vc * 16) = sv; } while (0)
    int kt = tA0, buf = 0;
    if (kt >= tA1) kt = tB0;
    if (kt < tB1) { AB_GLOAD(kt); AB_LSTORE(0); }
    __syncthreads();
    while (kt < tB1) {
        const int ktn = (kt + 1 == tA1) ? tB0 : kt + 1;
        if (ktn < tB1) AB_GLOAD(ktn);
        const int key0 = kt * 64;
        const bool live = !masked || key0 < CL || !((key0 - CL) + 63 < t0 - 128 || (key0 - CL) > t0 + 31 + 128);
        if (live) {
            const LAS unsigned char* sb = lds + buf * STAGE;
            bf16x8_t kf[4][NKS], vf[2][4];
#pragma unroll
            for (int blk = 0; blk < 4; ++blk)
#pragma unroll
                for (int ks = 0; ks < NKS; ++ks) kf[blk][ks] = *(const LAS bf16x8_t*)(sb + (16 * blk + r) * KP + 64 * ks + 16 * g);
#pragma unroll
            for (int sub = 0; sub < 2; ++sub)
#pragma unroll
                for (int nb = 0; nb < 4; ++nb) vf[sub][nb] = *(const LAS bf16x8_t*)(sb + KBYTES + (16 * nb + r) * VP + 64 * sub + 16 * g);
#pragma unroll
            for (int qb = 0; qb < 2; ++qb) {
                f32x4 s[4];
#pragma unroll
                for (int blk = 0; blk < 4; ++blk) { s[blk] = (f32x4){0.f, 0.f, 0.f, 0.f};
#pragma unroll
                    for (int ks = 0; ks < NKS; ++ks) s[blk] = __builtin_amdgcn_mfma_f32_16x16x32_bf16(kf[blk][ks], qf[qb][ks], s[blk], 0, 0, 0); }
                float tmax = -INFINITY;
#pragma unroll
                for (int blk = 0; blk < 4; ++blk)
#pragma unroll
                    for (int i = 0; i < 4; ++i) { float x = s[blk][i] * sc_l2;
                        if (masked) { const int kk = key0 + 16 * blk + 4 * g + i; const int dj = (t0 + 16 * qb + r) - (kk - CL); if (kk >= CL && (dj > 128 || dj < -128)) x = -INFINITY; }
                        s[blk][i] = x; tmax = fmaxf(tmax, x); }
                tmax = fmaxf(tmax, __shfl_xor(tmax, 16)); tmax = fmaxf(tmax, __shfl_xor(tmax, 32));
                const bool rebase = __any(tmax > mrun[qb] + 8.0f);
                const float mn = rebase ? fmaxf(mrun[qb], tmax) : mrun[qb];
                float p[16], ps = 0.f;
#pragma unroll
                for (int blk = 0; blk < 4; ++blk)
#pragma unroll
                    for (int i = 0; i < 4; ++i) { p[blk * 4 + i] = __builtin_amdgcn_exp2f(s[blk][i] - mn); ps += p[blk * 4 + i]; }
                if (rebase) { const float corr = __builtin_amdgcn_exp2f(mrun[qb] - mn); lrun[qb] *= corr;
#pragma unroll
                    for (int nb = 0; nb < 4; ++nb) oacc[qb][nb] = oacc[qb][nb] * corr; }
                lrun[qb] += ps; mrun[qb] = mn;
                bf16x8_t pb[2];
#pragma unroll
                for (int sub = 0; sub < 2; ++sub) { v4u pw; pw.x = pk2(p[8 * sub], p[8 * sub + 1]); pw.y = pk2(p[8 * sub + 2], p[8 * sub + 3]); pw.z = pk2(p[8 * sub + 4], p[8 * sub + 5]); pw.w = pk2(p[8 * sub + 6], p[8 * sub + 7]);
                    pb[sub] = __builtin_bit_cast(bf16x8_t, pw); }
#pragma unroll
                for (int nb = 0; nb < 4; ++nb) {
                    oacc[qb][nb] = __builtin_amdgcn_mfma_f32_16x16x32_bf16(vf[0][nb], pb[0], oacc[qb][nb], 0, 0, 0);
                    oacc[qb][nb] = __builtin_amdgcn_mfma_f32_16x16x32_bf16(vf[1][nb], pb[1], oacc[qb][nb], 0, 0, 0); }
            }
        }
        if (ktn < tB1) AB_LSTORE(buf ^ 1);
        __syncthreads();
        kt = ktn; buf ^= 1;
    }
#undef AB_GLOAD
#undef AB_LSTORE
#pragma unroll
    for (int qb = 0; qb < 2; ++qb) {
        float l = lrun[qb]; l += __shfl_xor(l, 16); l += __shfl_xor(l, 32);
        float fin = 1.f;
        if (has_sink) { const float mn = fmaxf(mrun[qb], sink_l2); const float corr = __builtin_amdgcn_exp2f(mrun[qb] - mn); l = l * corr + __builtin_amdgcn_exp2f(sink_l2 - mn); fin = corr; }
        const float inv = fin / l;
#pragma unroll
        for (int nb = 0; nb < 4; ++nb) { const f32x4 o = oacc[qb][nb] * inv; v2u w; w.x = pk2(o.x, o.y); w.y = pk2(o.z, o.w);
            *(v2u*)(O + (size_t)(16 * qb + r) * D + 16 * nb + 4 * g) = w; }
    }
}

struct Args { const float* in[29]; float* out; unsigned char* ws; int ph_lo, ph_hi, rep_mask, pad; };
enum { I_X = 0, I_C, I_CTX, I_CCTX, I_WMOD, I_BMOD, I_NORM1, I_NORM2, I_WIN, I_WOUT, I_SWAQN, I_SWAKN, I_SINK, I_CONV, I_ALOG, I_DTB, I_GONORM,
       I_QANORM, I_WUQ, I_KVANORM, I_WUKV, I_MQN, I_MKN, I_RW, I_RB, I_WGU, I_BGU, I_WDN, I_BDN };

template <int MODE> __device__ __forceinline__ void tr_item(const float* W, int K, int N, bf16* WT, LAS float* scr, int item, int nblk, int lane) {
    const int kb = item / nblk, nb = item % nblk, k0 = 64 * kb, n0 = 64 * nb;
    const int nsrc = n0 + lane;
    float wv[64];
#pragma unroll
    for (int i = 0; i < 64; ++i) wv[i] = (nsrc < N) ? W[(size_t)(k0 + i) * N + nsrc] : 0.f;
#pragma unroll
    for (int i = 0; i < 64; ++i) scr[i * 65 + lane] = wv[i];
    LDS_WAIT(); asm volatile("" ::: "memory");
    const int c = lane & 7;
#pragma unroll
    for (int j = 0; j < 8; ++j) { const int n = (lane >> 3) + 8 * j; const LAS float* s = scr + (8 * c) * 65 + n;
        v4u o; o.x = pk2(s[0 * 65], s[1 * 65]); o.y = pk2(s[2 * 65], s[3 * 65]); o.z = pk2(s[4 * 65], s[5 * 65]); o.w = pk2(s[6 * 65], s[7 * 65]);
        const int col = n0 + n; const int drow = (MODE == 1) ? (((col >> 1) >> 7) * 256 + (col & 1) * 128 + ((col >> 1) & 127)) : col;
        *(v4u*)(WT + (size_t)drow * K + k0 + 8 * c) = o; }
    LDS_WAIT(); asm volatile("" ::: "memory");
}

__device__ __forceinline__ void norm_mod_row(const f32x4 (&v)[4], const float* gain, const float* shift, const float* scale, bf16* orow, int lane) {
    float ss = 0.f;
#pragma unroll
    for (int j = 0; j < 4; ++j) ss += (v[j].x * v[j].x + v[j].y * v[j].y) + (v[j].z * v[j].z + v[j].w * v[j].w);
    const float rstd = rsqrtf(wave_sum(ss) * (1.f / D) + EPS);
#pragma unroll
    for (int j = 0; j < 4; ++j) { const int idx = j * 256 + lane * 4;
        const f32x4 g = *(const f32x4*)(gain + idx), sh = *(const f32x4*)(shift + idx), sc = *(const f32x4*)(scale + idx);
        const f32x4 y = v[j] * rstd * g * (sc + 1.f) + sh;
        v2u o; o.x = pk2(y.x, y.y); o.y = pk2(y.z, y.w); *(v2u*)(orow + idx) = o; }
}

template <int DQK>
__device__ __forceinline__ void attn_unit_mfma(const bf16* Q, int qpitch, const bf16* K, const bf16* Vt, int kta0, int kta1, int ktb0, int ktb1,
                                               int t0, bool masked, float sc_l2, bool has_sink, float sink_l2, bf16* O, int lane) {
    constexpr int NKS = DQK / 32;
    const int r = lane & 15, g = lane >> 4;
    bf16x8_t qf[2][NKS];
#pragma unroll
    for (int qb = 0; qb < 2; ++qb)
#pragma unroll
        for (int ks = 0; ks < NKS; ++ks) qf[qb][ks] = *(const bf16x8_t*)(Q + (size_t)(16 * qb + r) * qpitch + 32 * ks + 8 * g);
    f32x4 oacc[2][4];
#pragma unroll
    for (int qb = 0; qb < 2; ++qb)
#pragma unroll
        for (int nb = 0; nb < 4; ++nb) oacc[qb][nb] = (f32x4){0.f, 0.f, 0.f, 0.f};
    float mrun[2] = {-INFINITY, -INFINITY}, lrun[2] = {0.f, 0.f};
    bf16x8_t nkf[2][NKS], nvf[4];
#define ATT_LOAD(kt_) do { const int key0_ = (kt_) * 32; \
        _Pragma("unroll") for (int blk = 0; blk < 2; ++blk) _Pragma("unroll") for (int ks = 0; ks < NKS; ++ks) nkf[blk][ks] = *(const bf16x8_t*)(K + (size_t)(key0_ + 16 * blk + r) * DQK + 32 * ks + 8 * g); \
        _Pragma("unroll") for (int nb = 0; nb < 4; ++nb) nvf[nb] = *(const bf16x8_t*)(Vt + (size_t)(16 * nb + r) * 2304 + key0_ + 8 * g); } while (0)
    if (kta0 < ktb1) ATT_LOAD(kta0);
    for (int kt = kta0; kt < ktb1;) {
        const int ktn = (kt + 1 == kta1) ? ktb0 : kt + 1;
        const int key0 = kt * 32;
        bf16x8_t kf[2][NKS], vf[4];
#pragma unroll
        for (int blk = 0; blk < 2; ++blk)
#pragma unroll
            for (int ks = 0; ks < NKS; ++ks) kf[blk][ks] = nkf[blk][ks];
#pragma unroll
        for (int nb = 0; nb < 4; ++nb) vf[nb] = nvf[nb];
        if (ktn < ktb1) ATT_LOAD(ktn);
#pragma unroll
        for (int qb = 0; qb < 2; ++qb) {
            f32x4 s[2];
#pragma unroll
            for (int blk = 0; blk < 2; ++blk) { s[blk] = (f32x4){0.f, 0.f, 0.f, 0.f};
#pragma unroll
                for (int ks = 0; ks < NKS; ++ks) s[blk] = __builtin_amdgcn_mfma_f32_16x16x32_bf16(kf[blk][ks], qf[qb][ks], s[blk], 0, 0, 0); }
            float tmax = -INFINITY;
#pragma unroll
            for (int blk = 0; blk < 2; ++blk)
#pragma unroll
                for (int i = 0; i < 4; ++i) { float x = s[blk][i] * sc_l2;
                    if (masked) { const int kk = key0 + 16 * blk + 4 * g + i; const int dj = (t0 + 16 * qb + r) - (kk - CL); if (kk >= CL && (dj > 128 || dj < -128)) x = -INFINITY; }
                    s[blk][i] = x; tmax = fmaxf(tmax, x); }
            tmax = fmaxf(tmax, __shfl_xor(tmax, 16)); tmax = fmaxf(tmax, __shfl_xor(tmax, 32));
            const float mn = fmaxf(mrun[qb], tmax);
            const float corr = __builtin_amdgcn_exp2f(mrun[qb] - mn);
            float p[8], ps = 0.f;
#pragma unroll
            for (int blk = 0; blk < 2; ++blk)
#pragma unroll
                for (int i = 0; i < 4; ++i) { p[blk * 4 + i] = __builtin_amdgcn_exp2f(s[blk][i] - mn); ps += p[blk * 4 + i]; }
            lrun[qb] = lrun[qb] * corr + ps; mrun[qb] = mn;
            v4u pw; pw.x = pk2(p[0], p[1]); pw.y = pk2(p[2], p[3]); pw.z = pk2(p[4], p[5]); pw.w = pk2(p[6], p[7]);
            const bf16x8_t pb = __builtin_bit_cast(bf16x8_t, pw);
#pragma unroll
            for (int nb = 0; nb < 4; ++nb) { oacc[qb][nb] = oacc[qb][nb] * corr; oacc[qb][nb] = __builtin_amdgcn_mfma_f32_16x16x32_bf16(vf[nb], pb, oacc[qb][nb], 0, 0, 0); }
        }
        kt = ktn;
    }
#undef ATT_LOAD
#pragma unroll
    for (int qb = 0; qb < 2; ++qb) {
        float l = lrun[qb]; l += __shfl_xor(l, 16); l += __shfl_xor(l, 32);
        float fin = 1.f;
        if (has_sink) { const float mn = fmaxf(mrun[qb], sink_l2); const float corr = __builtin_amdgcn_exp2f(mrun[qb] - mn); l = l * corr + __builtin_amdgcn_exp2f(sink_l2 - mn); fin = corr; }
        const float inv = fin / l;
#pragma unroll
        for (int nb = 0; nb < 4; ++nb) { const f32x4 o = oacc[qb][nb] * inv; v2u w; w.x = pk2(o.x, o.y); w.y = pk2(o.z, o.w);
            *(v2u*)(O + (size_t)(16 * qb + r) * D + 16 * nb + 4 * g) = w; }
    }
}

constexpr int KT = CL + SEQ;
#define OPAQ(p) asm volatile("" : "+s"(p))
#ifndef PROBE_REP
#define PROBE_REP 0
#endif
#define REPEAT(cls) for (int rep_ = 0, nrep_ = 1 + ((rep_mask >> (cls)) & 1); rep_ < nrep_; ++rep_)
#define WSP(T, name, off) T* name = (T*)(wsb + (off))
#define CAS __attribute__((address_space(4)))
typedef const float* cfp_t;
#define PHASE_VIEW() const CAS unsigned char* kap = (const CAS unsigned char*)__builtin_amdgcn_kernarg_segment_ptr(); OPAQ(kap); \
    const CAS cfp_t* inp = (const CAS cfp_t*)kap; unsigned char* wsb = *(unsigned char* const CAS*)(kap + offsetof(Args, ws)); (void)inp; (void)wsb; \
    unsigned ones_ = ~0u; OPAQ(ones_); int tid = wave0 * 64 + (int)__builtin_amdgcn_mbcnt_hi(ones_, __builtin_amdgcn_mbcnt_lo(ones_, 0u)); asm volatile("" : "+v"(tid)); int bid = bid0; OPAQ(bid); int G = G0; OPAQ(G); \
    const int lane = tid & 63, wave = __builtin_amdgcn_readfirstlane(tid >> 6), gw = bid * NWAVES + wave, NGW = G * NWAVES; (void)lane; (void)gw; (void)NGW
__global__ void __launch_bounds__(NTHR, 2) fwd(Args args) {
    extern __shared__ __attribute__((aligned(16))) unsigned char lds_raw[];
    LAS unsigned char* lds = (LAS unsigned char*)lds_raw;
    volatile LAS unsigned* MISC = (volatile LAS unsigned*)(lds + MISC_OFF);
    const int wave0 = __builtin_amdgcn_readfirstlane((int)threadIdx.x >> 6), bid0 = blockIdx.x, G0 = gridDim.x;

    if (threadIdx.x < 64) MISC[threadIdx.x] = 0u;
    __syncthreads();
    const int lo = args.ph_lo, hi = args.ph_hi, rep_mask = args.rep_mask;
    XcdBarrier bar; bar.bar = (unsigned*)(args.ws + WS_CTL) + CW_BAR; bar.x = 0; bar.st = nullptr;
    if (hi - lo > 1) bar = xcd_barrier_post((unsigned*)(args.ws + WS_CTL) + CW_BAR, MISC + 8);
#define IN(k) (lo <= (k) && (k) < hi)
#define SEAM(k) do { if (IN(k) && IN((k) + 1)) { for (int br_ = 0, nbr_ = 1 + ((rep_mask >> 16) & 1); br_ < nbr_; ++br_) { XcdBarrier b2 = bar; OPAQ(b2.bar); xcd_barrier(b2); } } } while (0)

    if (IN(0)) REPEAT(0) {
        PHASE_VIEW();
        WSP(float, MODV, WS_MODV); WSP(float, BGU, WS_BGU); WSP(bf16, WIN, WS_WIN); WSP(bf16, WOUT, WS_WOUT); WSP(bf16, WGU, WS_WGU); WSP(bf16, WDN, WS_WDN);
        for (int item = bid; item < 2 * 96; item += G) {
            const int l = item / 96, n0 = (item % 96) * 64;
            LAS float* sil = (LAS float*)lds;
            LAS float* red = (LAS float*)(lds + 69632);
            __syncthreads();
            for (int i = tid; i < 17 * 1024; i += NTHR) { const int r = i >> 10, k = i & 1023; const float cv = (r < 16) ? inp[I_C][r * 1024 + k] : inp[I_CCTX][k]; sil[i] = siluf(cv); }
            __syncthreads();
            float acc[17];
#pragma unroll
            for (int r = 0; r < 17; ++r) acc[r] = 0.f;
            const float* wp = inp[I_WMOD] + ((size_t)l * 1024 + wave * 128) * NMODC + n0 + lane;
#pragma unroll 1
            for (int k0 = 0; k0 < 128; k0 += 32) { float wv[32];
#pragma unroll
                for (int k = 0; k < 32; ++k) wv[k] = wp[(size_t)(k0 + k) * NMODC];
#pragma unroll
                for (int k = 0; k < 32; ++k)
#pragma unroll
                    for (int r = 0; r < 17; ++r) acc[r] += sil[r * 1024 + wave * 128 + k0 + k] * wv[k]; }
#pragma unroll
            for (int r = 0; r < 17; ++r) red[(wave * 17 + r) * 64 + lane] = acc[r];
            __syncthreads();
            for (int i = tid; i < 17 * 64; i += NTHR) { const int r = i >> 6, cix = i & 63; float s = inp[I_BMOD][l * NMODC + n0 + cix];
#pragma unroll
                for (int w = 0; w < 8; ++w) s += red[(w * 17 + r) * 64 + cix];
                MODV[((size_t)l * 17 + r) * NMODC + n0 + cix] = s; }
        }
        __syncthreads();
        {
            LAS float* scr = (LAS float*)(lds + wave * 16896);
            constexpr int I_GU1 = 16 * 32, I_DN1 = 16 * 16, I_IN1 = 16 * 48, I_OUT1 = 16 * 16;
            constexpr int N_GU = 64 * I_GU1, N_DN = 64 * I_DN1, N_IN = 2 * I_IN1, N_OUT = 2 * I_OUT1;
            for (int it = gw; it < N_GU + N_DN + N_IN + N_OUT; it += NGW) {
                int r = it;
                if (r < N_GU) { const int mtx = r / I_GU1; tr_item<1>(inp[I_WGU] + (size_t)mtx * 1024 * 2048, 1024, 2048, WGU + (size_t)mtx * 2048 * 1024, scr, r % I_GU1, 32, lane); continue; } r -= N_GU;
                if (r < N_DN) { const int mtx = r / I_DN1; tr_item<0>(inp[I_WDN] + (size_t)mtx * 1024 * 1024, 1024, 1024, WDN + (size_t)mtx * 1024 * 1024, scr, r % I_DN1, 16, lane); continue; } r -= N_DN;
                if (r < N_IN) { const int mtx = r / I_IN1; tr_item<0>(inp[I_WIN] + (size_t)mtx * 1024 * NIN, 1024, NIN, WIN + (size_t)mtx * NINP * 1024, scr, r % I_IN1, 48, lane); continue; } r -= N_IN;
                { const int mtx = r / I_OUT1; tr_item<0>(inp[I_WOUT] + (size_t)mtx * 1024 * 1024, 1024, 1024, WOUT + (size_t)mtx * 1024 * 1024, scr, r % I_OUT1, 16, lane); }
            }
        }
        { WSP(bf16, RWH, WS_RWH); WSP(bf16, RWL, WS_RWL);
          for (int i = bid * NTHR + tid; i < 2 * 32 * 1024; i += G * NTHR) { const int k = i & 1023, e = (i >> 10) & 31, l2 = i >> 15;
              const float w = inp[I_RW][((size_t)l2 * 1024 + k) * 32 + e]; const unsigned hi16 = f2bf(w); RWH[i] = (bf16)hi16; RWL[i] = (bf16)f2bf(w - __builtin_bit_cast(float, hi16 << 16)); } }
        { WSP(bf16, WUQF, WS_WUQF); WSP(bf16, WUKVF, WS_WUKVF);
          for (int i = bid * NTHR + tid; i < 2 * 384 * 256; i += G * NTHR) { const int k = i & 255, n = (i >> 8) % 384, l2 = i / (384 * 256);
              WUQF[i] = (bf16)f2bf(inp[I_WUQ][((size_t)l2 * 256 + k) * 384 + n] * inp[I_QANORM][l2 * 256 + k]); }
          for (int i = bid * NTHR + tid; i < 2 * 512 * 128; i += G * NTHR) { const int k = i & 127, n = (i >> 7) & 511, l2 = i >> 16;
              WUKVF[i] = (bf16)f2bf(inp[I_WUKV][((size_t)l2 * 128 + k) * 512 + n] * inp[I_KVANORM][l2 * 128 + k]); } }
        for (int i = bid * NTHR + tid; i < 2 * 32 * 2048; i += G * NTHR) { const int np = i & 2047, le = i >> 11; const int pn = np >> 8, bj = (np >> 7) & 1, j = np & 127;
            BGU[i] = inp[I_BGU][(size_t)le * 2048 + 2 * (128 * pn + j) + bj]; }
    }
    SEAM(0);

    if (IN(1)) {
        PHASE_VIEW();
        WSP(float, MODV, WS_MODV); WSP(bf16, H, WS_H);
        for (int row = gw; row < MT; row += NGW) {
            const float* xr = (row < ML) ? inp[I_X] + (size_t)row * D : inp[I_CTX] + (size_t)(row - ML) * D;
            const int b = (row < ML) ? row / SEQ : NB;
            f32x4 v[4];
#pragma unroll
            for (int j = 0; j < 4; ++j) v[j] = *(const f32x4*)(xr + j * 256 + lane * 4);
            const float* mv = MODV + (size_t)b * NMODC;
            norm_mod_row(v, inp[I_NORM1], mv + 0 * D, mv + 1 * D, H + (size_t)row * D, lane);
        }
    }
    SEAM(1);

    constexpr int NPL = 9;
    for (int l = 0; l < 2; ++l) {
        const int pb = 2 + l * NPL;
        const int MROWS = (l == 0) ? MT : ML;

        if (IN(pb + 0)) REPEAT(2) {
            PHASE_VIEW();
            WSP(bf16, H, WS_H); WSP(bf16, WIN, WS_WIN); WSP(bf16, P, WS_P);
            pg8::Gemm g{H, WIN + (size_t)l * NINP * 1024, MT, NINP, 1024}; pg8::StaticOrder S; S.init(MT, NINP, G, bid);
            pg8::EpiStoreBf16 E{P, NINP};
            pg8::gemm_phase<pg8::EpiStoreBf16, pg8::StaticOrder, true, true>(lds, g, S, E, wave0, 1 + ((rep_mask >> 22) & 1));
        }
        SEAM(pb + 0);

        if (IN(pb + 1)) REPEAT(3) {
            PHASE_VIEW();
            WSP(bf16, P, WS_P);
            REPEAT(13) {
                WSP(bf16, QA, WS_QA); WSP(bf16, KA, WS_KA); WSP(bf16, VAT, WS_VA);
                const float* qn = inp[I_SWAQN] + l * 64; const float* kn = inp[I_SWAKN] + l * 64;
                const int d0 = (lane & 15) * 4;
                const f32x4 gq4 = *(const f32x4*)(qn + d0), gk4 = *(const f32x4*)(kn + d0);
                const int ax = d0 >> 5, ph = (d0 >> 4) & 1, f0 = d0 & 15;
                float fr4[4];
#pragma unroll
                for (int i = 0; i < 4; ++i) fr4[i] = exp2f(-(float)(f0 + i) * (13.287712379549449f / 16.f));
                LAS bf16* vtw = (LAS bf16*)(lds + wave * 9216);
                for (int grp = wave * G + bid; grp < MT / 32; grp += NGW) {
                    const int row0 = grp * 32; const bool lat = row0 < ML;
                    const int b = lat ? (row0 >> 11) : ((row0 - ML) >> 8); const int kk0 = lat ? (CL + (row0 & (SEQ - 1))) : ((row0 - ML) & (CL - 1));
                    v2u rq[4], rk[4]; bf16 rv[4][2];
#pragma unroll
                    for (int u = 0; u < 4; ++u) { const bf16* pr = P + (size_t)(row0 + u) * NINP; rq[u] = *(const v2u*)(pr + PC_AQ + 4 * lane); rk[u] = *(const v2u*)(pr + PC_AK + 4 * (lane & 31));
                        rv[u][0] = pr[PC_AV + lane]; rv[u][1] = pr[PC_AV + 64 + lane]; }
#pragma unroll 1
                    for (int tb = 0; tb < 8; ++tb) {
                        v2u nq[4], nk[4]; bf16 nv[4][2];
                        const int rn = row0 + ((tb + 1) & 7) * 4;
#pragma unroll
                        for (int u = 0; u < 4; ++u) { const bf16* pr = P + (size_t)(rn + u) * NINP; nq[u] = *(const v2u*)(pr + PC_AQ + 4 * lane); nk[u] = *(const v2u*)(pr + PC_AK + 4 * (lane & 31));
                            nv[u][0] = pr[PC_AV + lane]; nv[u][1] = pr[PC_AV + 64 + lane]; }
#pragma unroll
                        for (int u = 0; u < 4; ++u) {
                            const int ti = tb * 4 + u; const int row = row0 + ti; const int t = row & (SEQ - 1);
                            const float pos = (float)(ax == 0 ? (t >> 6) : (t & 63));
                            float cs[4], sn[4];
#pragma unroll
                            for (int i = 0; i < 4; ++i) { const float ang = pos * fr4[i]; cs[i] = __cosf(ang); sn[i] = __sinf(ang); }
#pragma unroll
                            for (int isk = 0; isk < 2; ++isk) {
                                const v2u raw = isk ? rk[u] : rq[u];
                                float x[4] = {bflo(raw.x), bfhi(raw.x), bflo(raw.y), bfhi(raw.y)};
                                float ss = (x[0] * x[0] + x[1] * x[1]) + (x[2] * x[2] + x[3] * x[3]);
                                ss += __shfl_xor(ss, 1); ss += __shfl_xor(ss, 2); ss += __shfl_xor(ss, 4); ss += __shfl_xor(ss, 8);
                                const float rs = rsqrtf(ss * (1.f / 64.f) + EPS);
                                const f32x4 gg = isk ? gk4 : gq4;
                                float y[4], yp[4];
#pragma unroll
                                for (int i = 0; i < 4; ++i) { y[i] = x[i] * rs * gg[i]; yp[i] = __shfl_xor(y[i], 4); }
                                if (lat) {
#pragma unroll
                                    for (int i = 0; i < 4; ++i) y[i] = (ph == 0) ? (y[i] * cs[i] - yp[i] * sn[i]) : (y[i] * cs[i] + yp[i] * sn[i]); }
                                v2u o; o.x = pk2(y[0], y[1]); o.y = pk2(y[2], y[3]);
                                if (!isk) *(v2u*)(QA + (size_t)row * 256 + 4 * lane) = o;
                                else if (lane < 32) *(v2u*)(KA + ((size_t)(b * 2 + (lane >> 4)) * KT + kk0 + ti) * 64 + d0) = o;
                            }
                            const int pp = ((ti & 12) << 1) | ((ti & 16) >> 2) | (ti & 3);
                            vtw[lane * 36 + pp] = rv[u][0]; vtw[(64 + lane) * 36 + pp] = rv[u][1];
                        }
#pragma unroll
                        for (int u = 0; u < 4; ++u) { rq[u] = nq[u]; rk[u] = nk[u]; rv[u][0] = nv[u][0]; rv[u][1] = nv[u][1]; }
                    }
                    asm volatile("s_waitcnt lgkmcnt(0)" ::: "memory");
#pragma unroll
                    for (int hk = 0; hk < 2; ++hk) { const LAS bf16* src = vtw + (hk * 64 + lane) * 36; bf16* dst = VAT + ((size_t)(b * 2 + hk) * 64 + lane) * KT + kk0;
#pragma unroll
                        for (int q4 = 0; q4 < 4; ++q4) { const v2u a0 = *(const LAS v2u*)(src + 8 * q4), a1 = *(const LAS v2u*)(src + 8 * q4 + 4); v4u o; o.x = a0.x; o.y = a0.y; o.z = a1.x; o.w = a1.y; *(v4u*)(dst + 8 * q4) = o; } }
                    asm volatile("s_waitcnt lgkmcnt(0)" ::: "memory");
                }
            }
            __syncthreads();
            REPEAT(14) {
                WSP(bf16, GW, WS_GW); WSP(bf16, GQD, WS_GQD); WSP(bf16, GKDT, WS_GKDT); WSP(bf16, GQKM, WS_GQKM); WSP(bf16, GUT, WS_GUT); WSP(float, GGE, WS_GGE);
                const float* cw = inp[I_CONV] + (size_t)l * 5 * 1536;
                LAS float* VF = (LAS float*)lds;
                LAS bf16* Qb = (LAS bf16*)(lds + 32768);
                LAS bf16* Kb = (LAS bf16*)(lds + 51200);
                LAS bf16* LH = (LAS bf16*)(lds + 69632);
                LAS bf16* LL = (LAS bf16*)(lds + 69632 + 18432);
                LAS bf16* TH = (LAS bf16*)(lds + 69632 + 36864);
                LAS bf16* TL = (LAS bf16*)(lds + 69632 + 47104);
                LAS float* GC = (LAS float*)(lds + 147456);
                LAS float* BT = GC + 128;
                const int c = lane & 15, g = lane >> 4;
                for (int item = bid; item < NB * 4 * 36; item += G) {
                    const int b = item / 144, hh = (item / 36) & 3, ct = item % 36;
                    const bool latc = ct >= 4; const int p0 = latc ? 64 * (ct - 4) : 64 * ct; const int Ls = latc ? SEQ : CL;
                    const int rowbase = latc ? b * SEQ + p0 : ML + b * CL + p0;
                    __syncthreads();
                    int tidl = tid; asm volatile("" : "+v"(tidl));
                    REPEAT(17) {
                        const int wv = __builtin_amdgcn_readfirstlane(tidl >> 6), ln = tidl & 63;
                        if (wv < 6) {
                            const int which = wv % 3, part = wv / 3, ch = which * 512 + hh * 128 + 2 * ln;
                            float w0[5], w1[5];
#pragma unroll
                            for (int w = 0; w < 5; ++w) { w0[w] = cw[w * 1536 + ch]; w1[w] = cw[w * 1536 + ch + 1]; }
                            unsigned xin[36];
#pragma unroll
                            for (int j = 0; j < 36; ++j) { const int tl = 32 * part - 2 + j; const int pos = p0 + tl;
                                xin[j] = (pos >= 0 && pos < Ls) ? *(const unsigned*)(P + (size_t)(rowbase + tl) * NINP + PC_GQ + ch) : 0u; }
                            float y0[32], y1[32];
#pragma unroll
                            for (int j = 0; j < 32; ++j) { float a0 = 0.f, a1 = 0.f;
#pragma unroll
                                for (int w = 0; w < 5; ++w) { a0 += bflo(xin[j + w]) * w0[w]; a1 += bfhi(xin[j + w]) * w1[w]; }
                                y0[j] = siluf(a0); y1[j] = siluf(a1); }
                            if (which == 2) {
#pragma unroll
                                for (int j = 0; j < 32; ++j) *(LAS f32x2_t*)(VF + (32 * part + j) * 128 + 2 * ln) = (f32x2_t){y0[j], y1[j]};
                            } else {
                                float p[32];
#pragma unroll
                                for (int j = 0; j < 32; ++j) p[j] = y0[j] * y0[j] + y1[j] * y1[j];
#pragma unroll
                                for (int k = 0; k < 5; ++k) { const bool bit = (ln >> k) & 1;
#pragma unroll
                                    for (int i = 0; i < (16 >> k); ++i) { const float keep = bit ? p[2 * i + 1] : p[2 * i], give = bit ? p[2 * i] : p[2 * i + 1]; p[i] = keep + __shfl_xor(give, 1 << k); } }
                                const float tot = p[0] + __shfl_xor(p[0], 32);
                                const float scl = rsqrtf(tot + EPS) * (which == 0 ? 0.08838834764831845f : 1.f);
                                LAS bf16* dstb = (which == 0 ? Qb : Kb) + (32 * part) * 144 + 2 * ln;
#pragma unroll
                                for (int j = 0; j < 32; ++j) { const float sj = __builtin_bit_cast(float, __builtin_amdgcn_readlane(__builtin_bit_cast(int, scl), j));
                                    *(LAS unsigned*)(dstb + j * 144) = pk2(y0[j] * sj, y1[j] * sj); }
                            }
                        } else {
                            const int dd = wv - 6, tl = dd ? 63 - ln : ln; const bf16* pr = P + (size_t)(rowbase + tl) * NINP;
                            const float a = bf2f(pr[PC_GA + dd * 4 + hh]) + inp[I_DTB][l * 8 + dd * 4 + hh];
                            const float ea = __expf(a); const float sp = (a > 20.f) ? a : ((a < -9.f) ? ea * (1.f - 0.5f * ea) : __logf(1.f + ea));
                            float gv = -__expf(inp[I_ALOG][l * 8 + dd * 4 + hh]) * sp;
                            BT[dd * 64 + ln] = 1.f / (1.f + __expf(-bf2f(pr[PC_GB + dd * 4 + hh])));
#pragma unroll
                            for (int off = 1; off < 64; off <<= 1) { const float tv = __shfl_up(gv, off); if (ln >= off) gv += tv; }
                            GC[dd * 64 + ln] = gv;
                        }
                    }
                    __syncthreads();
                    const int cs0 = ct, cs1 = (ct < 4) ? 3 - ct : 39 - ct;
                    const size_t it0 = ((size_t)(0 * NB + b) * 4 + hh) * 36 + cs0, it1 = ((size_t)(1 * NB + b) * 4 + hh) * 36 + cs1;
                    REPEAT(18) {
                        const int wv = __builtin_amdgcn_readfirstlane(tidl >> 6), c = tidl & 15, g = (tidl >> 4) & 3; const int mb = wv >> 1, nb0 = 2 * (wv & 1);
                        bf16x8_t ka[4];
#pragma unroll
                        for (int ks = 0; ks < 4; ++ks) ka[ks] = *(const LAS bf16x8_t*)(Kb + (16 * mb + c) * 144 + 32 * ks + 8 * g);
#pragma unroll
                        for (int nbi = 0; nbi < 2; ++nbi) { const int nb = nb0 + nbi;
                            f32x4 kk = (f32x4){0.f, 0.f, 0.f, 0.f}, qk = (f32x4){0.f, 0.f, 0.f, 0.f};
#pragma unroll
                            for (int ks = 0; ks < 4; ++ks) { const bf16x8_t kb = *(const LAS bf16x8_t*)(Kb + (16 * nb + c) * 144 + 32 * ks + 8 * g), qb = *(const LAS bf16x8_t*)(Qb + (16 * nb + c) * 144 + 32 * ks + 8 * g);
                                kk = __builtin_amdgcn_mfma_f32_16x16x32_bf16(ka[ks], kb, kk, 0, 0, 0); qk = __builtin_amdgcn_mfma_f32_16x16x32_bf16(ka[ks], qb, qk, 0, 0, 0); }
                            asm volatile("" ::: "memory");
#pragma unroll
                            for (int dd = 0; dd < 2; ++dd) {
                                const int s = dd ? 63 - 16 * nb - c : 16 * nb + c, ip0 = dd ? 60 - 16 * mb - 4 * g : 16 * mb + 4 * g;
                                const float gs = GC[dd * 64 + s], bs = BT[dd * 64 + s]; const f32x4 gi = *(const LAS f32x4*)(GC + dd * 64 + ip0);
                                float lv[4], qv[4];
#pragma unroll
                                for (int j = 0; j < 4; ++j) { const int ip = ip0 + j; const float dec = (ip <= s) ? __expf(gs - gi[j]) : 0.f; const int i = dd ? 3 - j : j;
                                    lv[j] = (ip < s) ? bs * kk[i] * dec : 0.f; qv[j] = qk[i] * dec; }
                                v2u h, lo; h.x = pk2(lv[0], lv[1]); h.y = pk2(lv[2], lv[3]);
                                lo.x = pk2(lv[0] - __builtin_bit_cast(float, h.x << 16), lv[1] - __builtin_bit_cast(float, h.x & 0xffff0000u));
                                lo.y = pk2(lv[2] - __builtin_bit_cast(float, h.y << 16), lv[3] - __builtin_bit_cast(float, h.y & 0xffff0000u));
                                *(LAS v2u*)(LH + (dd * 64 + s) * 72 + ip0) = h; *(LAS v2u*)(LL + (dd * 64 + s) * 72 + ip0) = lo;
                                v2u qo; qo.x = pk2(qv[0], qv[1]); qo.y = pk2(qv[2], qv[3]);
                                *(v2u*)(GQKM + (dd ? it1 : it0) * 4096 + (((s >> 4) * 2 + (ip0 >> 5)) * 64 + ((ip0 & 31) >> 3) * 16 + (s & 15)) * 8 + (ip0 & 7)) = qo; }
                        }
                    }
                    __syncthreads();
                    REPEAT(19) {
                        const int wv = __builtin_amdgcn_readfirstlane(tidl >> 6), ln = tidl & 63; const int dd = wv >> 2, blk = wv & 3;
                        if (ln < 16) { float t[16];
#pragma unroll
                            for (int r = 0; r < 16; ++r) { float acc = (r == ln) ? 1.f : 0.f;
                                const int off = (dd * 64 + 16 * blk + r) * 72 + 16 * blk;
                                if (r > 0) { const v4u h0 = *(const LAS v4u*)(LH + off), l0 = *(const LAS v4u*)(LL + off);
#pragma unroll
                                    for (int i = 0; i < (r < 8 ? r : 8); ++i) { const unsigned hw = h0[i >> 1], lw = l0[i >> 1]; acc -= ((i & 1) ? bfhi(hw) + bfhi(lw) : bflo(hw) + bflo(lw)) * t[i]; } }
                                if (r > 8) { const v4u h1 = *(const LAS v4u*)(LH + off + 8), l1 = *(const LAS v4u*)(LL + off + 8);
#pragma unroll
                                    for (int i = 8; i < r; ++i) { const unsigned hw = h1[(i - 8) >> 1], lw = l1[(i - 8) >> 1]; acc -= ((i & 1) ? bfhi(hw) + bfhi(lw) : bflo(hw) + bflo(lw)) * t[i]; } }
                                t[r] = acc; }
#pragma unroll
                            for (int r = 0; r < 16; ++r) { const unsigned hi16 = f2bf(t[r]); const int off = ((dd * 4 + blk) * 16 + r) * 40 + ln;
                                TH[off] = (bf16)hi16; TL[off] = (bf16)f2bf(t[r] - __builtin_bit_cast(float, hi16 << 16)); } }
                    }
                    __syncthreads();
                    REPEAT(20) {
                        const int wv = __builtin_amdgcn_readfirstlane(tidl >> 6), ln = tidl & 63, c = ln & 15, g = ln >> 4; const int dd = wv >> 2;
                        const size_t itd = dd ? it1 : it0;
                        const int ct0 = 4 * (wv & 3);
                        auto solve = [&](auto isu_c) {
                        constexpr bool isu = decltype(isu_c)::value;
                        v2u xb[4][4];
#pragma unroll
                        for (int q = 0; q < 4; ++q)
#pragma unroll
                            for (int k = 0; k < 4; ++k) xb[q][k] = (v2u){0u, 0u};
#pragma unroll
                        for (int blk = 0; blk < 4; ++blk) {
                            const int arow = (dd * 64 + 16 * blk + c) * 72 + 4 * g;
                            v4u ah[2], al[2];
#pragma unroll
                            for (int ch = 0; ch < 2; ++ch) if ((ch == 0 && blk >= 1) || (ch == 1 && blk == 3)) {
                                const v2u a0 = *(const LAS v2u*)(LH + arow + 32 * ch), a1 = *(const LAS v2u*)(LH + arow + 32 * ch + 16), b0 = *(const LAS v2u*)(LL + arow + 32 * ch), b1 = *(const LAS v2u*)(LL + arow + 32 * ch + 16);
                                ah[ch] = (v4u){a0.x, a0.y, a1.x, a1.y}; al[ch] = (v4u){b0.x, b0.y, b1.x, b1.y}; }
                            const int toff = ((dd * 4 + blk) * 16 + c) * 40 + 4 * g;
                            const v2u t0 = *(const LAS v2u*)(TH + toff), t1 = *(const LAS v2u*)(TL + toff);
                            const bf16x8_t th = __builtin_bit_cast(bf16x8_t, ((v4u){t0.x, t0.y, 0u, 0u})), tlw = __builtin_bit_cast(bf16x8_t, ((v4u){t1.x, t1.y, 0u, 0u}));
                            const f32x4 bt4 = *(const LAS f32x4*)(BT + dd * 64 + 16 * blk + 4 * g), gc4 = *(const LAS f32x4*)(GC + dd * 64 + 16 * blk + 4 * g);
                            float sc[4];
#pragma unroll
                            for (int i = 0; i < 4; ++i) sc[i] = isu ? bt4[i] : bt4[i] * __expf(gc4[i]);
                            f32x4 rhs[4];
#pragma unroll
                            for (int q = 0; q < 4; ++q) { const int cl = (16 * (ct0 + q) + c) & 127;
#pragma unroll
                                for (int i = 0; i < 4; ++i) { const int s = 16 * blk + 4 * g + i, tl = dd ? 63 - s : s;
                                    float rv; if constexpr (isu) rv = VF[tl * 128 + cl]; else rv = bf2f(Kb[tl * 144 + cl]);
                                    rhs[q][i] = sc[i] * rv; } }
#pragma unroll
                            for (int q = 0; q < 4; ++q) {
                                const int ctile = ct0 + q;
                                f32x4 prod = (f32x4){0.f, 0.f, 0.f, 0.f};
#pragma unroll
                                for (int ch = 0; ch < 2; ++ch) if ((ch == 0 && blk >= 1) || (ch == 1 && blk == 3)) {
                                    const bf16x8_t xbf = __builtin_bit_cast(bf16x8_t, ((v4u){xb[q][2 * ch].x, xb[q][2 * ch].y, xb[q][2 * ch + 1].x, xb[q][2 * ch + 1].y}));
                                    prod = __builtin_amdgcn_mfma_f32_16x16x32_bf16(__builtin_bit_cast(bf16x8_t, ah[ch]), xbf, prod, 0, 0, 0);
                                    prod = __builtin_amdgcn_mfma_f32_16x16x32_bf16(__builtin_bit_cast(bf16x8_t, al[ch]), xbf, prod, 0, 0, 0); }
                                const f32x4 y = rhs[q] - prod;
                                const bf16x8_t yb = __builtin_bit_cast(bf16x8_t, ((v4u){pk2(y.x, y.y), pk2(y.z, y.w), 0u, 0u}));
                                f32x4 x = (f32x4){0.f, 0.f, 0.f, 0.f};
                                x = __builtin_amdgcn_mfma_f32_16x16x32_bf16(th, yb, x, 0, 0, 0); x = __builtin_amdgcn_mfma_f32_16x16x32_bf16(tlw, yb, x, 0, 0, 0);
                                xb[q][blk].x = pk2(x.x, x.y); xb[q][blk].y = pk2(x.z, x.w);
                                if constexpr (isu) *(v2u*)(GUT + itd * 8192 + ((ctile * 4 + blk) * 64 + ln) * 4) = xb[q][blk];
                                else {
                                    f32x4 xt = (f32x4){0.f, 0.f, 0.f, 0.f};
                                    xt = __builtin_amdgcn_mfma_f32_16x16x32_bf16(yb, th, xt, 0, 0, 0); xt = __builtin_amdgcn_mfma_f32_16x16x32_bf16(yb, tlw, xt, 0, 0, 0);
                                    const int kd0 = 16 * (ctile - 8) + 4 * g; v2u o; o.x = pk2(xt.x, xt.y); o.y = pk2(xt.z, xt.w);
                                    *(v2u*)(GW + itd * 8192 + ((blk * 4 + (kd0 >> 5)) * 64 + ((kd0 & 31) >> 3) * 16 + c) * 8 + (kd0 & 7)) = o; }
                            }
                        }
                        };
                        if ((wv & 2) == 0) solve(std::true_type{}); else solve(std::false_type{});
                    }
                    REPEAT(21) {
                        WSP(bf16, GQN, WS_GQD); WSP(bf16, GKT, WS_GKDT); float* GCG = (float*)(wsb + WS_GQD + 40 * MiB);
                        const size_t iq = (size_t)(b * 4 + hh) * 36 + ct;
                        for (int f = tidl; f < 1024; f += NTHR) { const int mbq = f >> 8, ksq = (f >> 6) & 3, r = f & 15, gg = (f >> 4) & 3;
                            *(v4u*)(GQN + iq * 8192 + (size_t)f * 8) = *(const LAS v4u*)(Qb + (16 * mbq + r) * 144 + 32 * ksq + 8 * gg); }
                        for (int f = tidl; f < 1024; f += NTHR) { const int kbq = f >> 7, ksq = (f >> 6) & 1, r = f & 15, gg = (f >> 4) & 3; const int kd = 16 * kbq + r, tb = 32 * ksq + 8 * gg;
                            v4u o; o.x = (unsigned)Kb[(tb + 0) * 144 + kd] | ((unsigned)Kb[(tb + 1) * 144 + kd] << 16); o.y = (unsigned)Kb[(tb + 2) * 144 + kd] | ((unsigned)Kb[(tb + 3) * 144 + kd] << 16);
                            o.z = (unsigned)Kb[(tb + 4) * 144 + kd] | ((unsigned)Kb[(tb + 5) * 144 + kd] << 16); o.w = (unsigned)Kb[(tb + 6) * 144 + kd] | ((unsigned)Kb[(tb + 7) * 144 + kd] << 16);
                            *(v4u*)(GKT + iq * 8192 + (size_t)f * 8) = o; }
                        if (tidl < 128) GCG[((tidl >> 6) ? it1 : it0) * 64 + (tidl & 63)] = GC[tidl];
                    }
                }
            }
            __syncthreads();
            REPEAT(15) {
                WSP(bf16, QM, WS_QM); WSP(bf16, KM, WS_KM); WSP(bf16, VMT, WS_VM);
                const int per = (MT + G - 1) / G, r0 = bid * per, r1 = (r0 + per < MT) ? r0 + per : MT, ngrp = (r1 - r0 + 15) >> 4;
                LAS float* ssq = (LAS float*)lds;
                {
                    int ln_ = tid; asm volatile("" : "+v"(ln_)); const int c = ln_ & 15, g = (ln_ >> 4) & 3;
                    const float* gq = inp[I_MQN] + l * 96; WSP(bf16, WUQF, WS_WUQF);
                    bf16x8_t wf[3][8];
#pragma unroll
                    for (int nb = 0; nb < 3; ++nb)
#pragma unroll
                        for (int ks = 0; ks < 8; ++ks) wf[nb][ks] = *(const bf16x8_t*)(WUQF + ((size_t)l * 384 + 48 * wave + 16 * nb + c) * 256 + 32 * ks + 8 * g);
                    const int hh = wave >> 1, dbase = 48 * (wave & 1);
                    v4u nraw[8];
                    { const int rw = (r0 + c < r1) ? r0 + c : r1 - 1; const bf16* pr = P + (size_t)rw * NINP + PC_CQ + 8 * g;
#pragma unroll
                      for (int ks = 0; ks < 8; ++ks) nraw[ks] = *(const v4u*)(pr + 32 * ks); }
                    for (int grp = 0; grp < ngrp; ++grp) {
                        const int rowv = r0 + 16 * grp + c; const bool valid = rowv < r1; const int row = valid ? rowv : r1 - 1;
                        v4u craw[8];
#pragma unroll
                        for (int ks = 0; ks < 8; ++ks) craw[ks] = nraw[ks];
                        if (grp + 1 < ngrp) { const int rn = (rowv + 16 < r1) ? rowv + 16 : r1 - 1; const bf16* prn = P + (size_t)rn * NINP + PC_CQ + 8 * g;
#pragma unroll
                            for (int ks = 0; ks < 8; ++ks) nraw[ks] = *(const v4u*)(prn + 32 * ks); }
                        bf16x8_t xf[8]; float ss = 0.f;
#pragma unroll
                        for (int ks = 0; ks < 8; ++ks) { const v4u raw = craw[ks]; xf[ks] = __builtin_bit_cast(bf16x8_t, raw);
                            ss += bflo(raw.x) * bflo(raw.x) + bfhi(raw.x) * bfhi(raw.x) + bflo(raw.y) * bflo(raw.y) + bfhi(raw.y) * bfhi(raw.y)
                                + bflo(raw.z) * bflo(raw.z) + bfhi(raw.z) * bfhi(raw.z) + bflo(raw.w) * bflo(raw.w) + bfhi(raw.w) * bfhi(raw.w); }
                        ss += __shfl_xor(ss, 16); ss += __shfl_xor(ss, 32);
                        const float rstd = rsqrtf(ss * (1.f / 256.f) + EPS);
                        f32x4 acc[3]; float hs = 0.f;
#pragma unroll
                        for (int nb = 0; nb < 3; ++nb) { acc[nb] = (f32x4){0.f, 0.f, 0.f, 0.f};
#pragma unroll
                            for (int ks = 0; ks < 8; ++ks) acc[nb] = __builtin_amdgcn_mfma_f32_16x16x32_bf16(wf[nb][ks], xf[ks], acc[nb], 0, 0, 0);
                            acc[nb] = acc[nb] * rstd; hs += (acc[nb].x * acc[nb].x + acc[nb].y * acc[nb].y) + (acc[nb].z * acc[nb].z + acc[nb].w * acc[nb].w); }
                        hs += __shfl_xor(hs, 16); hs += __shfl_xor(hs, 32);
                        LAS float* sq = ssq + (grp & 1) * 128;
                        if (g == 0) sq[wave * 16 + c] = hs;
                        __syncthreads();
                        const float rs = rsqrtf((sq[wave * 16 + c] + sq[(wave ^ 1) * 16 + c]) * (1.f / 96.f) + EPS);
                        const bool lat = row < ML; const int t = row & (SEQ - 1);
#pragma unroll
                        for (int nb = 0; nb < 3; ++nb) { const int d0 = dbase + 16 * nb + 4 * g;
                            const f32x4 gv = *(const f32x4*)(gq + d0);
                            f32x4 y = acc[nb] * rs * gv;
                            if (d0 >= 64) {
                                f32x4 yp; yp.x = __shfl_xor(y.x, 32); yp.y = __shfl_xor(y.y, 32); yp.z = __shfl_xor(y.z, 32); yp.w = __shfl_xor(y.w, 32);
                                if (lat) { const int r = d0 - 64; const int ax = r >> 4, ph = (r >> 3) & 1; const float pos = (float)(ax == 0 ? (t >> 6) : (t & 63));
#pragma unroll
                                    for (int i = 0; i < 4; ++i) { const float ang = pos * exp2f(-(float)((r & 7) + i) * (13.287712379549449f / 8.f)); const float cs = __cosf(ang), sn = __sinf(ang);
                                        y[i] = (ph == 0) ? (y[i] * cs - yp[i] * sn) : (y[i] * cs + yp[i] * sn); } } }
                            if (valid) { v2u o; o.x = pk2(y.x, y.y); o.y = pk2(y.z, y.w); *(v2u*)(QM + (size_t)row * 384 + hh * 96 + d0) = o; } }
                    }
                }
                __syncthreads();
                {
                    int ln_ = tid; asm volatile("" : "+v"(ln_)); const int c = ln_ & 15, g = (ln_ >> 4) & 3;
                    const float* gk = inp[I_MKN] + l * 96; WSP(bf16, WUKVF, WS_WUKVF);
                    bf16x8_t wf[4][4];
#pragma unroll
                    for (int nb = 0; nb < 4; ++nb)
#pragma unroll
                        for (int ks = 0; ks < 4; ++ks) wf[nb][ks] = *(const bf16x8_t*)(WUKVF + ((size_t)l * 512 + 64 * wave + 16 * nb + c) * 128 + 32 * ks + 8 * g);
                    const int hh = wave >> 1;
                    v4u nraw[4], nrr;
                    { const int rw = (r0 + c < r1) ? r0 + c : r1 - 1; const bf16* pr = P + (size_t)rw * NINP + PC_CKV + 8 * g;
#pragma unroll
                      for (int ks = 0; ks < 4; ++ks) nraw[ks] = *(const v4u*)(pr + 32 * ks);
                      nrr = *(const v4u*)(P + (size_t)rw * NINP + PC_CKR + 8 * g); }
                    for (int grp = 0; grp < ngrp; ++grp) {
                        const int rowv = r0 + 16 * grp + c; const bool valid = rowv < r1; const int row = valid ? rowv : r1 - 1;
                        v4u craw[4]; const v4u rr = nrr;
#pragma unroll
                        for (int ks = 0; ks < 4; ++ks) craw[ks] = nraw[ks];
                        if (grp + 1 < ngrp) { const int rn = (rowv + 16 < r1) ? rowv + 16 : r1 - 1; const bf16* prn = P + (size_t)rn * NINP + PC_CKV + 8 * g;
#pragma unroll
                            for (int ks = 0; ks < 4; ++ks) nraw[ks] = *(const v4u*)(prn + 32 * ks);
                            nrr = *(const v4u*)(P + (size_t)rn * NINP + PC_CKR + 8 * g); }
                        bf16x8_t xf[4]; float ss = 0.f;
#pragma unroll
                        for (int ks = 0; ks < 4; ++ks) { const v4u raw = craw[ks]; xf[ks] = __builtin_bit_cast(bf16x8_t, raw);
                            ss += bflo(raw.x) * bflo(raw.x) + bfhi(raw.x) * bfhi(raw.x) + bflo(raw.y) * bflo(raw.y) + bfhi(raw.y) * bfhi(raw.y)
                                + bflo(raw.z) * bflo(raw.z) + bfhi(raw.z) * bfhi(raw.z) + bflo(raw.w) * bflo(raw.w) + bfhi(raw.w) * bfhi(raw.w); }
                        ss += __shfl_xor(ss, 16); ss += __shfl_xor(ss, 32);
                        const float rstd = rsqrtf(ss * (1.f / 128.f) + EPS);
                        f32x4 acc[4]; float hs = 0.f;
#pragma unroll
                        for (int nb = 0; nb < 4; ++nb) { acc[nb] = (f32x4){0.f, 0.f, 0.f, 0.f};
#pragma unroll
                            for (int ks = 0; ks < 4; ++ks) acc[nb] = __builtin_amdgcn_mfma_f32_16x16x32_bf16(wf[nb][ks], xf[ks], acc[nb], 0, 0, 0);
                            acc[nb] = acc[nb] * rstd; hs += (acc[nb].x * acc[nb].x + acc[nb].y * acc[nb].y) + (acc[nb].z * acc[nb].z + acc[nb].w * acc[nb].w); }
                        const bool lat = row < ML; const int t = row & (SEQ - 1);
                        const int b = lat ? (row >> 11) : ((row - ML) >> 8); const int kk = lat ? (CL + t) : ((row - ML) & (CL - 1));
                        if ((wave & 1) == 0) {
                            float kr[8] = {bflo(rr.x), bfhi(rr.x), bflo(rr.y), bfhi(rr.y), bflo(rr.z), bfhi(rr.z), bflo(rr.w), bfhi(rr.w)};
#pragma unroll
                            for (int j = 0; j < 8; ++j) hs += kr[j] * kr[j];
                            hs += __shfl_xor(hs, 16); hs += __shfl_xor(hs, 32);
                            const float rs = rsqrtf(hs * (1.f / 96.f) + EPS);
                            bf16* kd = KM + ((size_t)(b * 4 + hh) * KT + kk) * 96;
#pragma unroll
                            for (int nb = 0; nb < 4; ++nb) { const int d0 = 16 * nb + 4 * g; const f32x4 gv = *(const f32x4*)(gk + d0); const f32x4 y = acc[nb] * rs * gv;
                                if (valid) { v2u o; o.x = pk2(y.x, y.y); o.y = pk2(y.z, y.w); *(v2u*)(kd + d0) = o; } }
                            const int ax = g >> 1, ph = g & 1; const float pos = (float)(ax == 0 ? (t >> 6) : (t & 63));
                            float yr[8];
#pragma unroll
                            for (int j = 0; j < 8; ++j) { float y = kr[j] * rs * gk[64 + 8 * g + j]; const float yp = __shfl_xor(y, 16);
                                if (lat) { const float ang = pos * exp2f(-(float)j * (13.287712379549449f / 8.f)); const float cs = __cosf(ang), sn = __sinf(ang); y = (ph == 0) ? (y * cs - yp * sn) : (y * cs + yp * sn); }
                                yr[j] = y; }
                            if (valid) { v4u o; o.x = pk2(yr[0], yr[1]); o.y = pk2(yr[2], yr[3]); o.z = pk2(yr[4], yr[5]); o.w = pk2(yr[6], yr[7]); *(v4u*)(kd + 64 + 8 * g) = o; }
                        } else {
                            bf16* vd = VMT + (size_t)(b * 4 + hh) * 64 * KT + ((kk & ~31) | ((kk & 12) << 1) | ((kk & 16) >> 2) | (kk & 3));
                            if (valid) {
#pragma unroll
                                for (int nb = 0; nb < 4; ++nb)
#pragma unroll
                                    for (int i = 0; i < 4; ++i) vd[(size_t)(16 * nb + 4 * g + i) * KT] = (bf16)f2bf(acc[nb][i]); }
                        }
                    }
                }
            }
        }
        SEAM(pb + 1);

        if (IN(pb + 2)) {
            PHASE_VIEW();
            REPEAT(4) {
                WSP(bf16, GW, WS_GW); WSP(bf16, GQN, WS_GQD); WSP(bf16, GKT, WS_GKDT); WSP(bf16, GQKM, WS_GQKM); WSP(bf16, GUT, WS_GUT); WSP(bf16, OD, WS_OD); const float* GCG = (const float*)(wsb + WS_GQD + 40 * MiB);
                LAS bf16* ST = (LAS bf16*)lds;
                LAS bf16* VT = (LAS bf16*)(lds + 36864);
                LAS bf16* VT2 = (LAS bf16*)(lds + 36864 + 20480);
                const int c = lane & 15, g = lane >> 4, mb = wave >> 1, nb0 = 4 * (wave & 1);
                const bool xcdaware = (G & 7) == 0 && G >= 128;
                const int nscan = xcdaware ? 128 : (G < 128 ? G : 128), sci = xcdaware ? ((bid >> 3) < 16 ? (bid >> 3) * 8 + (bid & 7) : 128) : (bid < 128 ? bid : 128);
                for (int ci = sci; ci < 128; ci += nscan) {
                    const int idx = ci >> 3, xq = ci & 7; const int dd = idx & 1, bh = (idx >> 1) * 8 + xq, b = bh >> 2, hh = bh & 3; const int chain = (dd * 16 + b) * 4 + hh;
                    __syncthreads();
                    { unsigned z_ = 0u; asm volatile("" : "+v"(z_));
                      for (int i = tid; i < 36864 / 16; i += NTHR) *(LAS v4u*)(lds + 16 * i) = (v4u){z_, z_, z_, z_}; }
                    f32x4 Sm[8];
#pragma unroll
                    for (int nb = 0; nb < 8; ++nb) Sm[nb] = (f32x4){0.f, 0.f, 0.f, 0.f};
                    const size_t itb = (size_t)chain * 36;
                    bf16x8_t nw[4], nq[4], nm[2], nk[2]; v2u nu[4]; f32x4 ngc; float nge;
                    const unsigned o_w = (unsigned)(mb * 4) * 1024u + (unsigned)lane * 16u;
                    const unsigned o_qn = dd ? (unsigned)((3 - mb) * 4) * 1024u + (unsigned)(g * 16 + (15 - c)) * 16u : o_w;
                    const unsigned o_m = (unsigned)(mb * 2) * 1024u + (unsigned)lane * 16u, o_k = (unsigned)(wave * 2) * 1024u + (unsigned)lane * 16u;
                    const unsigned o_u0 = (unsigned)((nb0 * 4 + mb) * 64 + lane) * 8u;
#define GDN_CT(cs_) (dd ? ((cs_) < 4 ? 3 - (cs_) : 39 - (cs_)) : (cs_))
#define GDN_LOAD_A(cs_) do { const size_t it_ = itb + (cs_); const size_t iq_ = (size_t)(b * 4 + hh) * 36 + GDN_CT(cs_); const char* bw_ = (const char*)GW + it_ * (64 * 128 * 2); const char* bq_ = (const char*)GQN + iq_ * (64 * 128 * 2); \
                        _Pragma("unroll") for (int ks = 0; ks < 4; ++ks) { nw[ks] = *(const bf16x8_t*)(bw_ + o_w + ks * 1024); nq[ks] = *(const bf16x8_t*)(bq_ + o_qn + ks * 1024); } } while (0)
#define GDN_LOAD_B(cs_) do { const size_t it_ = itb + (cs_); const size_t iq_ = (size_t)(b * 4 + hh) * 36 + GDN_CT(cs_); const char* bm_ = (const char*)GQKM + it_ * (64 * 64 * 2); const char* bk_ = (const char*)GKT + iq_ * (128 * 64 * 2); const char* bu_ = (const char*)GUT + it_ * (128 * 64 * 2); \
                        _Pragma("unroll") for (int nbi = 0; nbi < 4; ++nbi) nu[nbi] = *(const v2u*)(bu_ + o_u0 + nbi * 2048); ngc = *(const f32x4*)(GCG + it_ * 64 + 16 * mb + 4 * g); nge = GCG[it_ * 64 + 63]; (void)bm_; (void)bk_; } while (0)
#define GDN_LOAD_C(cs_) do { const size_t it_ = itb + (cs_); const size_t iq_ = (size_t)(b * 4 + hh) * 36 + GDN_CT(cs_); const char* bm_ = (const char*)GQKM + it_ * (64 * 64 * 2); const char* bk_ = (const char*)GKT + iq_ * (128 * 64 * 2); \
                        _Pragma("unroll") for (int ks = 0; ks < 2; ++ks) { nm[ks] = *(const bf16x8_t*)(bm_ + o_m + ks * 1024); nk[ks] = *(const bf16x8_t*)(bk_ + o_k + ks * 1024); } } while (0)
                    GDN_LOAD_A(0); GDN_LOAD_B(0); GDN_LOAD_C(0);
                    __syncthreads();
                    for (int cs = 0; cs < 36; ++cs) {
                        bf16x8_t cw_[4], cq_[4], cm_[2], ck_[2]; v2u cu_[4];
#pragma unroll
                        for (int ks = 0; ks < 4; ++ks) { cw_[ks] = nw[ks]; cq_[ks] = nq[ks]; }
#pragma unroll
                        for (int ks = 0; ks < 2; ++ks) { cm_[ks] = nm[ks]; ck_[ks] = nk[ks]; }
#pragma unroll
                        for (int nbi = 0; nbi < 4; ++nbi) cu_[nbi] = nu[nbi];
                        const float gend = nge; const f32x4 gcv = ngc;
                        const float ge = __expf(gend);
                        f32x4 egc, egk;
#pragma unroll
                        for (int i = 0; i < 4; ++i) { egc[i] = __expf(gcv[i]); egk[i] = __expf(gend - gcv[i]); }
                        if (cs + 1 < 36) { GDN_LOAD_A(cs + 1); GDN_LOAD_B(cs + 1); }
                        f32x4 aws[4], aqs[4];
#pragma unroll
                        for (int nbi = 0; nbi < 4; ++nbi) { aws[nbi] = (f32x4){0.f, 0.f, 0.f, 0.f}; aqs[nbi] = (f32x4){0.f, 0.f, 0.f, 0.f};
#pragma unroll
                            for (int ks = 0; ks < 4; ++ks) { const bf16x8_t sf = *(const LAS bf16x8_t*)(ST + (16 * (nb0 + nbi) + c) * 144 + 32 * ks + 8 * g);
                                aws[nbi] = __builtin_amdgcn_mfma_f32_16x16x32_bf16(cw_[ks], sf, aws[nbi], 0, 0, 0); aqs[nbi] = __builtin_amdgcn_mfma_f32_16x16x32_bf16(cq_[ks], sf, aqs[nbi], 0, 0, 0); }
                            const f32x4 uu = (f32x4){bflo(cu_[nbi].x), bfhi(cu_[nbi].x), bflo(cu_[nbi].y), bfhi(cu_[nbi].y)}; const f32x4 vn = uu - aws[nbi];
                            aqs[nbi] = aqs[nbi] * egc;
                            v2u o; o.x = pk2(vn.x, vn.y); o.y = pk2(vn.z, vn.w); *(LAS v2u*)(VT + (16 * (nb0 + nbi) + c) * 80 + 16 * mb + 4 * g) = o;
                            const f32x4 vs = vn * egk;
                            v2u o2; if (dd) { o2.x = pk2(vs.w, vs.z); o2.y = pk2(vs.y, vs.x); } else { o2.x = pk2(vs.x, vs.y); o2.y = pk2(vs.z, vs.w); }
                            *(LAS v2u*)(VT2 + (16 * (nb0 + nbi) + c) * 80 + (dd ? 60 - 16 * mb - 4 * g : 16 * mb + 4 * g)) = o2; }
                        __syncthreads();
                        if (cs + 1 < 36) GDN_LOAD_C(cs + 1);
                        const int ct = dd ? (cs < 4 ? 3 - cs : 39 - cs) : cs; const int rowbase = (ct >= 4) ? b * SEQ + 64 * (ct - 4) : ML + b * CL + 64 * ct;
#pragma unroll
                        for (int nb = 0; nb < 8; ++nb) { bf16x8_t vf2[2];
#pragma unroll
                            for (int ks = 0; ks < 2; ++ks) vf2[ks] = *(const LAS bf16x8_t*)(VT2 + (16 * nb + c) * 80 + 32 * ks + 8 * g);
                            Sm[nb] = Sm[nb] * ge;
#pragma unroll
                            for (int ks = 0; ks < 2; ++ks) Sm[nb] = __builtin_amdgcn_mfma_f32_16x16x32_bf16(ck_[ks], vf2[ks], Sm[nb], 0, 0, 0); }
#pragma unroll
                        for (int nbi = 0; nbi < 4; ++nbi)
#pragma unroll
                            for (int ks = 0; ks < 2; ++ks) { const bf16x8_t vf = *(const LAS bf16x8_t*)(VT + (16 * (nb0 + nbi) + c) * 80 + 32 * ks + 8 * g);
                                aqs[nbi] = __builtin_amdgcn_mfma_f32_16x16x32_bf16(cm_[ks], vf, aqs[nbi], 0, 0, 0); }
#pragma unroll
                        for (int nbi = 0; nbi < 4; ++nbi)
#pragma unroll
                            for (int i = 0; i < 4; ++i) { const int s = 16 * mb + 4 * g + i; const int tl = dd ? 63 - s : s;
                                OD[((size_t)dd * MT + rowbase + tl) * 512 + hh * 128 + 16 * (nb0 + nbi) + c] = (bf16)f2bf(aqs[nbi][i]); }
#pragma unroll
                        for (int nb = 0; nb < 8; ++nb) { v2u o; o.x = pk2(Sm[nb].x, Sm[nb].y); o.y = pk2(Sm[nb].z, Sm[nb].w); *(LAS v2u*)(ST + (16 * nb + c) * 144 + 16 * wave + 4 * g) = o; }
                        __syncthreads();
                    }
#undef GDN_LOAD_A
#undef GDN_LOAD_B
#undef GDN_LOAD_C
#undef GDN_CT
                }
            }
            __syncthreads();
            REPEAT(5) {
                WSP(bf16, QA, WS_QA); WSP(bf16, KA, WS_KA); WSP(bf16, VAT, WS_VA); WSP(bf16, QM, WS_QM); WSP(bf16, KM, WS_KM); WSP(bf16, VMT, WS_VM); WSP(bf16, MIX, WS_MIX);
                constexpr float L2E = 1.4426950408889634f;
                const int NU_ML = NB * 4 * 8, NU_SL = NB * 4 * 8, NU_C = (l == 0) ? NB * 4 : 0;
                const int NX = (G % 8 == 0) ? 8 : 1, xx = bid % NX, BPX = G / NX, lb = bid / NX;
                const int NUx_ML = NU_ML / NX, NUx_SL = NU_SL / NX, NUx_C = NU_C / NX;
                unsigned* aq = (unsigned*)(wsb + WS_CTL) + CW_AQ + (l * 8 + xx) * 64; (void)lb; (void)BPX;
                for (;;) {
                    __syncthreads();
                    if (tid == 0) MISC[44] = __hip_atomic_fetch_add(aq, 1u, __ATOMIC_RELAXED, __HIP_MEMORY_SCOPE_AGENT);
                    __syncthreads();
                    const int li = __builtin_amdgcn_readfirstlane((int)MISC[44]);
                    if (li >= NUx_ML + NUx_SL + 2 * NUx_C) break;
                    int r = li;
                    if (r < NUx_ML) {
                        const int bh = (r >> 3) * NX + xx, qt = r & 7; const int b = bh >> 2, hh = bh & 3; const int row = b * SEQ + qt * 256;
                        attn_block<96>(lds, QM + (size_t)row * 384 + hh * 96, 384, KM + (size_t)(b * 4 + hh) * KT * 96, VMT + (size_t)(b * 4 + hh) * 64 * KT, 0, KT / 64, KT / 64, KT / 64,
                                       qt * 256, false, 0.10206207261596575f * L2E, false, 0.f, MIX + (size_t)row * D + 768 + hh * 64, tid);
                        continue; }
                    r -= NUx_ML;
                    if (r < NUx_SL) {
                        const int bk = (r >> 4) * NX + xx, hql = (r >> 3) & 1, qt = r & 7; const int b = bk >> 1, hk = bk & 1, hq = hk * 2 + hql; const int row = b * SEQ + qt * 256;
                        const int ja = (qt * 256 - 128) < 0 ? 0 : (qt * 256 - 128), jb = (qt * 256 + 384) > SEQ ? SEQ : (qt * 256 + 384);
                        attn_block<64>(lds, QA + (size_t)row * 256 + hq * 64, 256, KA + (size_t)(b * 2 + hk) * KT * 64, VAT + (size_t)(b * 2 + hk) * 64 * KT, 0, CL / 64, (CL + ja) / 64, (CL + jb) / 64,
                                       qt * 256, true, 0.125f * L2E, true, inp[I_SINK][l * 4 + hq] * L2E, MIX + (size_t)row * D + hq * 64, tid);
                        continue; }
                    r -= NUx_SL;
                    if (r < NUx_C) {
                        const int bk = (r >> 1) * NX + xx, hql = r & 1; const int b = bk >> 1, hk = bk & 1, hq = hk * 2 + hql; const int row = ML + b * CL;
                        attn_block<64>(lds, QA + (size_t)row * 256 + hq * 64, 256, KA + (size_t)(b * 2 + hk) * KT * 64, VAT + (size_t)(b * 2 + hk) * 64 * KT, 0, CL / 64, CL / 64, CL / 64,
                                       0, false, 0.125f * L2E, true, inp[I_SINK][l * 4 + hq] * L2E, MIX + (size_t)row * D + hq * 64, tid);
                        continue; }
                    r -= NUx_C;
                    {
                        const int bh = r * NX + xx; const int b = bh >> 2, hh = bh & 3; const int row = ML + b * CL;
                        attn_block<96>(lds, QM + (size_t)row * 384 + hh * 96, 384, KM + (size_t)(b * 4 + hh) * KT * 96, VMT + (size_t)(b * 4 + hh) * 64 * KT, 0, CL / 64, CL / 64, CL / 64,
                                       0, false, 0.10206207261596575f * L2E, false, 0.f, MIX + (size_t)row * D + 768 + hh * 64, tid);
                    }
                }
            }
        }
        SEAM(pb + 2);

        if (IN(pb + 3)) REPEAT(6) {
            PHASE_VIEW();
            WSP(bf16, OD, WS_OD); WSP(bf16, P, WS_P); WSP(bf16, MIX, WS_MIX);
            const float* gn = inp[I_GONORM] + l * 128;
            for (int it = gw; it < MROWS * 4; it += NGW) {
                const int row = it >> 2, hh = it & 3;
                const size_t oo = (size_t)row * 512 + hh * 128 + lane * 2;
                const unsigned of = *(const unsigned*)(OD + oo), ob = *(const unsigned*)(OD + (size_t)MT * 512 + oo); const float o0 = bflo(of) + bflo(ob), o1 = bfhi(of) + bfhi(ob);
                const float rs = rsqrtf(wave_sum(o0 * o0 + o1 * o1) * (1.f / 128.f) + EPS);
                const unsigned zz = *(const unsigned*)(P + (size_t)row * NINP + PC_GZ + hh * 128 + lane * 2);
                const float y0 = o0 * rs * gn[lane * 2] * siluf(bflo(zz)), y1 = o1 * rs * gn[lane * 2 + 1] * siluf(bfhi(zz));
                *(unsigned*)(MIX + (size_t)row * D + 256 + hh * 128 + lane * 2) = pk2(y0, y1);
            }
        }
        SEAM(pb + 3);

        if (IN(pb + 4)) {
            PHASE_VIEW();
            WSP(bf16, MIX, WS_MIX); WSP(bf16, WOUT, WS_WOUT); WSP(bf16, XW, WS_XW); WSP(float, MODV, WS_MODV);
            pg8::Gemm g{MIX, WOUT + (size_t)l * 1024 * 1024, MROWS, 1024, 1024}; pg8::StaticOrder S; S.init(MROWS, 1024, G, bid);
            pg8::EpiResid E{inp[I_X], inp[I_CTX], l == 0 ? (const bf16*)nullptr : XW, XW, MODV + (size_t)l * 17 * NMODC};
            pg8::gemm_phase<pg8::EpiResid, pg8::StaticOrder, true, true>(lds, g, S, E, wave0);
        }
        SEAM(pb + 4);

        if (IN(pb + 5)) REPEAT(8) {
            PHASE_VIEW();
            WSP(bf16, XW, WS_XW); WSP(bf16, H, WS_H); WSP(float, MODV, WS_MODV); WSP(int, PAIRE, WS_PAIRE); WSP(int, PAIRR, WS_PAIRR); WSP(float, PAIRG, WS_PAIRG);
            WSP(bf16, RWH, WS_RWH); WSP(bf16, RWL, WS_RWL);
            unsigned* cntw = (unsigned*)(wsb + WS_CTL) + CW_CNT + l * 32 * 64;
            const float* modv = MODV + (size_t)l * 17 * NMODC;
            constexpr int HSP = 1028;
            LAS float* hs = (LAS float*)lds;
            LAS float* part = (LAS float*)(lds + 66048);
            LAS int* lcount = (LAS int*)(lds + 82432);
            LAS int* lbase = (LAS int*)(lds + 82432 + 128);
            LAS int* tke = (LAS int*)(lds + 82688);
            LAS int* tkr = (LAS int*)(lds + 82688 + 10240);
            LAS float* tkg = (LAS float*)(lds + 82688 + 20480);
            const int per = (MROWS + G - 1) / G;
            const int t0 = bid * per, t1 = (t0 + per < MROWS) ? t0 + per : MROWS;
            __syncthreads();
            if (tid < 32) lcount[tid] = 0;
            const float* rb = inp[I_RB] + l * 32;
            const int c = lane & 15, g = lane >> 4;
            const bf16* rwh = RWH + (size_t)l * 32 * 1024; const bf16* rwl = RWL + (size_t)l * 32 * 1024;
            bf16x8_t rah[4][2], ral[4][2];
#pragma unroll
            for (int ks = 0; ks < 4; ++ks)
#pragma unroll
                for (int nb = 0; nb < 2; ++nb) { const size_t o = (size_t)(16 * nb + c) * 1024 + 128 * wave + 32 * ks + 8 * g; rah[ks][nb] = *(const bf16x8_t*)(rwh + o); ral[ks][nb] = *(const bf16x8_t*)(rwl + o); }
            f32x4 nv[2][4];
#define G_LOADROWS(rd_) do { _Pragma("unroll") for (int q = 0; q < 2; ++q) { int row_ = (rd_) + wave * 2 + q; row_ = row_ < t1 ? row_ : t1 - 1; _Pragma("unroll") for (int j = 0; j < 4; ++j) { const v2u w_ = *(const v2u*)(XW + (size_t)row_ * D + j * 256 + lane * 4); nv[q][j] = (f32x4){bflo(w_.x), bfhi(w_.x), bflo(w_.y), bfhi(w_.y)}; } } } while (0)
            G_LOADROWS(t0);
            for (int rd = t0; rd < t1; rd += 16) {
                __syncthreads();
#pragma unroll
                for (int q = 0; q < 2; ++q) {
                    const int tk = wave * 2 + q; const int row = rd + tk;
                    if (row < t1) {
                        const int b = (row < ML) ? row / SEQ : NB; const float* mv = modv + (size_t)b * NMODC;
                        f32x4 v[4]; float ss = 0.f;
#pragma unroll
                        for (int j = 0; j < 4; ++j) { v[j] = nv[q][j]; ss += (v[j].x * v[j].x + v[j].y * v[j].y) + (v[j].z * v[j].z + v[j].w * v[j].w); }
                        const float rstd = rsqrtf(wave_sum(ss) * (1.f / D) + EPS);
#pragma unroll
                        for (int j = 0; j < 4; ++j) { const int idx = j * 256 + lane * 4;
                            const f32x4 gn = *(const f32x4*)(inp[I_NORM2] + l * D + idx), sh = *(const f32x4*)(mv + 3 * D + idx), sc = *(const f32x4*)(mv + 4 * D + idx);
                            const f32x4 y = v[j] * rstd * gn * (sc + 1.f) + sh;
                            v2u o; o.x = pk2(y.x, y.y); o.y = pk2(y.z, y.w); *(v2u*)(H + (size_t)row * D + idx) = o;
                            *(LAS f32x4*)(hs + tk * HSP + idx) = y; }
                    } else { float z0 = 0.f; asm volatile("" : "+v"(z0));
#pragma unroll
                        for (int j = 0; j < 4; ++j) *(LAS f32x4*)(hs + tk * HSP + j * 256 + lane * 4) = (f32x4){z0, z0, z0, z0};
                    }
                }
                __syncthreads();
                if (rd + 16 < t1) G_LOADROWS(rd + 16);
                {
                    f32x4 acc[2] = {(f32x4){0.f, 0.f, 0.f, 0.f}, (f32x4){0.f, 0.f, 0.f, 0.f}};
#pragma unroll
                    for (int ks = 0; ks < 4; ++ks) { const int k0 = 128 * wave + 32 * ks + 8 * g;
                        const f32x4 h0 = *(const LAS f32x4*)(hs + c * HSP + k0), h1 = *(const LAS f32x4*)(hs + c * HSP + k0 + 4);
                        const float hv[8] = {h0.x, h0.y, h0.z, h0.w, h1.x, h1.y, h1.z, h1.w};
                        v4u whi, wlo; unsigned* ph = (unsigned*)&whi; unsigned* pl = (unsigned*)&wlo;
#pragma unroll
                        for (int j = 0; j < 8; j += 2) { const unsigned a = f2bf(hv[j]), b2 = f2bf(hv[j + 1]);
                            ph[j >> 1] = a | (b2 << 16);
                            pl[j >> 1] = pk2(hv[j] - __builtin_bit_cast(float, a << 16), hv[j + 1] - __builtin_bit_cast(float, b2 << 16)); }
                        const bf16x8_t bh = __builtin_bit_cast(bf16x8_t, whi), bl = __builtin_bit_cast(bf16x8_t, wlo);
#pragma unroll
                        for (int nb = 0; nb < 2; ++nb) { const bf16x8_t ah = rah[ks][nb], al = ral[ks][nb];
                            acc[nb] = __builtin_amdgcn_mfma_f32_16x16x32_bf16(ah, bh, acc[nb], 0, 0, 0);
                            acc[nb] = __builtin_amdgcn_mfma_f32_16x16x32_bf16(al, bh, acc[nb], 0, 0, 0);
                            acc[nb] = __builtin_amdgcn_mfma_f32_16x16x32_bf16(ah, bl, acc[nb], 0, 0, 0); } }
#pragma unroll
                    for (int nb = 0; nb < 2; ++nb) *(LAS f32x4*)(part + (wave * 16 + c) * 32 + 16 * nb + 4 * g) = acc[nb];
                }
                __syncthreads();
                {
                    const int tk = tid >> 5, e = tid & 31; const int row = rd + tk;
                    float lg = rb[e];
#pragma unroll
                    for (int w = 0; w < 8; ++w) lg += part[(w * 16 + tk) * 32 + e];
                    float vv = lg; int se[4]; float sl[4];
#pragma unroll
                    for (int kk = 0; kk < 4; ++kk) { float mx = vv;
#pragma unroll
                        for (int off = 16; off >= 1; off >>= 1) mx = fmaxf(mx, __shfl_xor(mx, off));
                        const unsigned long long bal = __ballot(vv == mx); const int ee = __ffs((unsigned)(bal >> (lane & 32))) - 1;
                        se[kk] = ee; sl[kk] = mx; if (e == ee) vv = -INFINITY; }
                    const float p1 = __expf(sl[1] - sl[0]), p2 = __expf(sl[2] - sl[0]), p3 = __expf(sl[3] - sl[0]); const float inv = 1.f / (1.f + p1 + p2 + p3);
                    if (e < 4 && row < t1) { const int ee = e == 0 ? se[0] : e == 1 ? se[1] : e == 2 ? se[2] : se[3];
                        const float gg = (e == 0 ? 1.f : e == 1 ? p1 : e == 2 ? p2 : p3) * inv;
                        const int lr = __hip_atomic_fetch_add(lcount + ee, 1, __ATOMIC_RELAXED, __HIP_MEMORY_SCOPE_WORKGROUP);
                        const int ti = row - t0; tke[ti * 4 + e] = ee; tkr[ti * 4 + e] = lr; tkg[ti * 4 + e] = gg; }
                }
            }
            __syncthreads();
#undef G_LOADROWS
            if (rep_ + 1 < nrep_) continue;
            if (tid < 32) lbase[tid] = (int)__hip_atomic_fetch_add(cntw + tid * 64, (unsigned)lcount[tid], __ATOMIC_RELAXED, __HIP_MEMORY_SCOPE_AGENT);
            __syncthreads();
            { WSP(int, TOKE, WS_TOKE); WSP(float, GATEE, WS_GATEE);
              for (int i = tid; i < (t1 - t0) * 4; i += NTHR) { const int ee = tke[i], rk = lbase[ee] + tkr[i]; PAIRE[(size_t)t0 * 4 + i] = ee; PAIRR[(size_t)t0 * 4 + i] = rk;
                  TOKE[(size_t)ee * MT + rk] = t0 + (i >> 2); GATEE[(size_t)ee * MT + rk] = tkg[i]; } }
        }
        SEAM(pb + 5);

        LAS int* tstart = (LAS int*)(lds + TAB_OFF);
        if (IN(pb + 6) || IN(pb + 7) || IN(pb + 8)) {
            PHASE_VIEW(); unsigned* cntw = (unsigned*)(wsb + WS_CTL) + CW_CNT + l * 32 * 64;
            __syncthreads();
            if (tid == 0) { int acc = 0; for (int e2 = 0; e2 < NE; ++e2) { tstart[e2] = acc; const unsigned c = __hip_atomic_load(cntw + e2 * 64, __ATOMIC_RELAXED, __HIP_MEMORY_SCOPE_AGENT); tstart[33 + e2] = (int)c; acc += (int)((c + 255u) >> 8); } tstart[NE] = acc; }
            __syncthreads();
        }
        if (IN(pb + 6)) REPEAT(10) {
            PHASE_VIEW();
            WSP(bf16, H, WS_H); WSP(bf16, WGU, WS_WGU); WSP(bf16, ACT, WS_ACT); WSP(float, BGU, WS_BGU); WSP(int, TOK, WS_TOKE);
            pg8::Gemm g{H, WGU + (size_t)l * 32 * 2048 * 1024, 0, 0, 1024}; LAS unsigned short* rtab = (LAS unsigned short*)(lds + TAB_OFF + 512);
            pg8::MoeOrderT<true> S{tstart, tstart[NE], 8, G, bid, TOK, rtab}; S.preload(rtab, tid); __syncthreads();
            pg8::EpiSwiglu E{ACT, BGU + (size_t)l * 32 * 2048};
            pg8::gemm_phase<pg8::EpiSwiglu, pg8::MoeOrderT<true>, true, true>(lds, g, S, E, wave0, 1 + ((rep_mask >> 22) & 1));
        }
        SEAM(pb + 6);

        if (IN(pb + 7)) REPEAT(11) {
            PHASE_VIEW();
            WSP(bf16, ACT, WS_ACT); WSP(bf16, WDN, WS_WDN); WSP(bf16, Y, WS_Y); WSP(float, SLOTG, WS_GATEE);
            pg8::Gemm g{ACT, WDN + (size_t)l * 32 * 1024 * 1024, 0, 0, 1024}; pg8::MoeOrderT<false> S{tstart, tstart[NE], 4, G, bid, nullptr, nullptr};
            pg8::EpiDown E{Y, inp[I_BDN] + (size_t)l * 32 * 1024, SLOTG, tstart};
            pg8::gemm_phase<pg8::EpiDown, pg8::MoeOrderT<false>, true, true>(lds, g, S, E, wave0, 1 + ((rep_mask >> 22) & 1));
        }
        SEAM(pb + 7);

        if (IN(pb + 8)) for (int rep_ = 0, nrep_ = 1 + ((rep_mask >> 12) & l & 1); rep_ < nrep_; ++rep_) {
            PHASE_VIEW();
            WSP(bf16, XW, WS_XW); WSP(bf16, H, WS_H); WSP(bf16, Y, WS_Y); WSP(float, MODV, WS_MODV); WSP(int, PAIRE, WS_PAIRE); WSP(int, PAIRR, WS_PAIRR);
            for (int row = gw; row < MROWS; row += NGW) {
                const int b = (row < ML) ? row / SEQ : NB; const float* mv = MODV + ((size_t)l * 17 + b) * NMODC;
                f32x4 y[4];
#pragma unroll
                for (int j = 0; j < 4; ++j) y[j] = (f32x4){0.f, 0.f, 0.f, 0.f};
#pragma unroll
                for (int k = 0; k < 4; ++k) { const int slot = tstart[PAIRE[(size_t)row * 4 + k]] * 256 + PAIRR[(size_t)row * 4 + k];
#pragma unroll
                    for (int j = 0; j < 4; ++j) { const v2u w = *(const v2u*)(Y + (size_t)slot * D + j * 256 + lane * 4);
                        y[j].x += bflo(w.x); y[j].y += bfhi(w.x); y[j].z += bflo(w.y); y[j].w += bfhi(w.y); } }
                f32x4 v[4];
#pragma unroll
                for (int j = 0; j < 4; ++j) { const int idx = j * 256 + lane * 4; const f32x4 g5 = *(const f32x4*)(mv + 5 * D + idx);
                    const v2u xw = *(const v2u*)(XW + (size_t)row * D + idx); v[j] = (f32x4){bflo(xw.x), bfhi(xw.x), bflo(xw.y), bfhi(xw.y)} + g5 * y[j]; }
                if (l == 0) {
#pragma unroll
                    for (int j = 0; j < 4; ++j) { v2u o; o.x = pk2(v[j].x, v[j].y); o.y = pk2(v[j].z, v[j].w); *(v2u*)(XW + (size_t)row * D + j * 256 + lane * 4) = o; }
                    const float* mv1 = MODV + (size_t)(17 + b) * NMODC;
                    norm_mod_row(v, inp[I_NORM1] + D, mv1 + 0 * D, mv1 + 1 * D, H + (size_t)row * D, lane);
                } else {
#pragma unroll
                    for (int j = 0; j < 4; ++j) *(f32x4*)((*(float* const CAS*)(kap + offsetof(Args, out))) + (size_t)row * D + j * 256 + lane * 4) = v[j];
                }
            }
        }
        SEAM(pb + 8);
    }
#undef IN
#undef SEAM
}

extern "C" void kernel_launch(void* const* d_in, const int* in_sizes, int n_in, void* d_out, int out_size, void* d_ws, size_t ws_size, hipStream_t stream) {
    static int grid = 0;
    if (grid == 0) {
        if (n_in != 29 || out_size != ML * D || ws_size < WS_END) { fprintf(stderr, "kernel_launch: unexpected shapes (n_in %d, out %d, ws %zu < %zu)\n", n_in, out_size, ws_size, (size_t)WS_END); grid = -1; return; }
        int dev = 0, cus = 0, per_cu = 0;
        if (hipGetDevice(&dev) != hipSuccess || hipDeviceGetAttribute(&cus, hipDeviceAttributeMultiprocessorCount, dev) != hipSuccess) { grid = -1; return; }
        if (hipFuncSetAttribute((const void*)fwd, hipFuncAttributeMaxDynamicSharedMemorySize, LDS_BYTES) != hipSuccess) { fprintf(stderr, "kernel_launch: hipFuncSetAttribute failed\n"); grid = -1; return; }
        if (hipOccupancyMaxActiveBlocksPerMultiprocessor(&per_cu, (const void*)fwd, NTHR, LDS_BYTES) != hipSuccess || per_cu < 1) fprintf(stderr, "kernel_launch: occupancy query says %d\n", per_cu);
        (void)hipGetLastError();
        grid = cus > 256 ? 256 : cus;
        if (grid < 224 || (grid & 7)) { fprintf(stderr, "kernel_launch: this build needs a 224..256-CU device (multiple of 8), got %d\n", cus); grid = -1; return; }
    }
    if (grid < 0) return;
    (void)hipMemsetAsync((char*)d_ws + WS_CTL, 0, CTL_ZERO_BYTES, stream);
    Args a{};
    for (int i = 0; i < 29; ++i) a.in[i] = (const float*)d_in[i];
    a.out = (float*)d_out; a.ws = (unsigned char*)d_ws; a.rep_mask = PROBE_REP; a.pad = 0;
    constexpr int NPH = 20;
#if MK_PER_PHASE
    for (int p = 0; p < NPH; ++p) { a.ph_lo = p; a.ph_hi = p + 1; hipLaunchKernelGGL(fwd, dim3(grid), dim3(NTHR), LDS_BYTES, stream, a); }
#else
    a.ph_lo = 0; a.ph_hi = NPH; hipLaunchKernelGGL(fwd, dim3(grid), dim3(NTHR), LDS_BYTES, stream, a);
#endif
}
```

```cpp
#include <hip/hip_runtime.h>
#include <cstdio>
#include <cstdint>
#include <cstddef>
#include <type_traits>
#ifndef MK_PER_PHASE
#define MK_PER_PHASE 0
#endif
namespace pg8 {
#define PG8_LAS __attribute__((address_space(3)))
typedef unsigned short bf16_t;
typedef short bf16x8 __attribute__((ext_vector_type(8)));
typedef float f32x4 __attribute__((ext_vector_type(4)));
typedef unsigned u32x4 __attribute__((ext_vector_type(4)));
constexpr int BM = 256, BK = 64, HALF = 128, HTB = HALF * BK * 2  , STAGE_BYTES = 8 * HTB, NXCD = 8, WGM = 8;

__host__ __device__ __forceinline__ int lds_byte(int r, int c) { const int f = r & 7; return (r >> 3) * 1024 + f * 128 + ((((c >> 3) ^ f) & 7) << 4) + (c & 7) * 2; }
__host__ __device__ __forceinline__ void stage_rc(int b, int& R, int& C) { const int pc = b / 1024, wb = b % 1024, f = wb >> 7, sc = (wb >> 4) & 7; R = pc * 8 + f; C = ((sc ^ f) << 3) + ((wb & 15) >> 1); }
__host__ __device__ __forceinline__ int perm32(int rho) { const int n = rho >> 4, i = rho & 15; return 8 * (i >> 2) + 4 * n + (i & 3); }

struct Unit { int pm, pn; };
struct Gemm { const bf16_t* A; const bf16_t* Bt; int M, N, K; };

struct StaticOrder {
    static constexpr bool GATHER = false;
    int nM, nN, nwg, G, c;
    __host__ __device__ void init(int M, int N, int G_, int c_) { nM = M / BM; nN = N / BM; nwg = nM * nN; G = G_; c = c_; }
    __host__ __device__ bool next(int i, Unit& u) const {
        const long L = (long)i * G + c; if (L >= nwg) return false;
        int wgid = (int)L; { const int q = nwg / NXCD, r = nwg % NXCD, xcd = wgid % NXCD, off = wgid / NXCD; wgid = (xcd < r ? xcd * (q + 1) : r * (q + 1) + (xcd - r) * q) + off; }
        const int nig = WGM * nN, gid = wgid / nig, fm = gid * WGM, gsz = (nM - fm) < WGM ? (nM - fm) : WGM;
        u.pm = fm + ((wgid % nig) % gsz); u.pn = (wgid % nig) / gsz; return true;
    }
    __device__ __forceinline__ void a_ready(const Unit&) const {}
    __device__ __forceinline__ void done(const Unit&) const {}
};

__device__ __forceinline__ unsigned cvt_pk_bf16(float lo, float hi) { unsigned r; asm volatile("v_cvt_pk_bf16_f32 %0, %1, %2" : "=v"(r) : "v"(lo), "v"(hi)); return r; }
typedef float f32x2 __attribute__((ext_vector_type(2)));
template <class Epi, class Sched, bool ALIGN_EPI = false, bool SP2 = false>
__device__ __forceinline__ void gemm_phase(PG8_LAS unsigned char* lds, const Gemm g, const Sched& S, const Epi& E, const int wave_s  , const int epi_reps = 1) {
    unsigned ones_ = ~0u; asm volatile("" : "+s"(ones_));
    int tid_raw = wave_s * 64 + (int)__builtin_amdgcn_mbcnt_hi(ones_, __builtin_amdgcn_mbcnt_lo(ones_, 0u)); asm volatile("" : "+v"(tid_raw));
    const int tid = tid_raw, wid = __builtin_amdgcn_readfirstlane(tid >> 6), lane = tid & 63, wr = wid >> 2, wc = wid & 3, fr = lane & 15, fq = lane >> 4;
    const int K = g.K, nt = K / BK;
    unsigned voffA[2], voffB[2];
#pragma unroll
    for (int i = 0; i < 2; ++i) { int R, C; stage_rc(tid * 16 + i * 8192, R, C); const int Rb = Epi::PERM ? ((R & ~31) + perm32(R & 31)) : R;
        voffA[i] = (unsigned)(R * K + C) * 2u; voffB[i] = (unsigned)(Rb * K + C) * 2u; }
    unsigned gA[2][2], gAn[2][2];
    const size_t kstep = (size_t)(BK * 2);
    const size_t hstep = (size_t)HALF * K * 2;
    const size_t tstep = 2 * hstep;
    const unsigned ldsw = (unsigned)wid * 1024u;
    const int aoff = lds_byte(wr * 64 + fr, fq * 8), boff = lds_byte(wc * 32 + fr, fq * 8);
#define PG8_SA(b, h) (((b) * 2 + (h)) * HTB)
#define PG8_SB(b, h) ((4 + (b) * 2 + (h)) * HTB)
#define PG8_STAGE(bufoff, gbase, voff) do { _Pragma("unroll") for (int _i = 0; _i < 2; ++_i) \
        __builtin_amdgcn_global_load_lds((const unsigned*)((const char*)(gbase) + (voff)[_i]), (PG8_LAS unsigned*)(lds + (bufoff) + ldsw + _i * 8192), 16, 0, 0); } while (0)
#define PG8_STAGE_A(bufoff, base, h, nx) do { if constexpr (Sched::GATHER) { _Pragma("unroll") for (int _i = 0; _i < 2; ++_i) \
        __builtin_amdgcn_global_load_lds((const unsigned*)((const char*)(base) + ((nx) ? gAn[h][_i] : gA[h][_i])), (PG8_LAS unsigned*)(lds + (bufoff) + ldsw + _i * 8192), 16, 0, 0); } \
    else { PG8_STAGE(bufoff, (base) + (h) * hstep, voffA); } } while (0)
#define PG8_LDA(dst, b, h) do { _Pragma("unroll") for (int m = 0; m < 4; ++m) _Pragma("unroll") for (int k = 0; k < 2; ++k) dst[m][k] = *(const PG8_LAS bf16x8*)(lds + PG8_SA(b, h) + (aoff ^ (k * 64)) + m * 2048); } while (0)
#define PG8_LDB(dst, b, h) do { _Pragma("unroll") for (int n = 0; n < 2; ++n) _Pragma("unroll") for (int k = 0; k < 2; ++k) dst[n][k] = *(const PG8_LAS bf16x8*)(lds + PG8_SB(b, h) + (boff ^ (k * 64)) + n * 2048); } while (0)
#define PG8_MMA(ai, bj, At, Bt) do { __builtin_amdgcn_s_setprio(1); _Pragma("unroll") for (int m = 0; m < 4; ++m) _Pragma("unroll") for (int n = 0; n < 2; ++n) _Pragma("unroll") for (int k = 0; k < 2; ++k) \
        acc[ai][bj][m][n] = __builtin_amdgcn_mfma_f32_16x16x32_bf16(Bt[n][k], At[m][k], acc[ai][bj][m][n], 0, 0, 0); __builtin_amdgcn_s_setprio(0); } while (0)
#define PG8_WAIT_V(n) asm volatile("s_waitcnt vmcnt(" #n ")" ::: "memory")
#define PG8_WAIT_L(n) asm volatile("s_waitcnt lgkmcnt(" #n ")" ::: "memory")
#define PG8_BAR __builtin_amdgcn_s_barrier()
#define PG8_SCHED __builtin_amdgcn_sched_barrier(0)
    Unit cur, nxt; int ui = 0;
    if (!S.next(0, cur)) return;
    f32x4 acc[2][2][4][2];
#pragma unroll
    for (int a = 0; a < 2; ++a)
#pragma unroll
        for (int b = 0; b < 2; ++b)
#pragma unroll
            for (int m = 0; m < 4; ++m)
#pragma unroll
                for (int n = 0; n < 2; ++n) acc[a][b][m][n] = (f32x4){0.f, 0.f, 0.f, 0.f};
    bf16x8 At[4][2], B0[2][2], B1[2][2];
    const char* cA = (const char*)g.A + (Sched::GATHER ? (size_t)0 : (size_t)cur.pm * tstep); const char* cB = (const char*)g.Bt + (size_t)cur.pn * tstep;
    S.a_ready(cur);
    if constexpr (Sched::GATHER) { S.rows(cur, 0, tid, K, gA);
#pragma unroll
        for (int h = 0; h < 2; ++h)
#pragma unroll
            for (int i = 0; i < 2; ++i) gAn[h][i] = gA[h][i]; }
    if constexpr (SP2) {
        PG8_STAGE(PG8_SB(0, 0), cB, voffB); PG8_STAGE(PG8_SB(0, 1), cB + hstep, voffB); PG8_STAGE_A(PG8_SA(0, 0), cA, 0, false); PG8_STAGE_A(PG8_SA(0, 1), cA, 1, false);
        if (wr == 1) PG8_BAR;
        PG8_WAIT_V(2); PG8_BAR;
        PG8_STAGE(PG8_SB(1, 0), cB + kstep, voffB); PG8_STAGE_A(PG8_SA(1, 0), cA + kstep, 0, false); PG8_STAGE(PG8_SB(1, 1), cB + hstep + kstep, voffB);
        PG8_WAIT_V(6); PG8_BAR;
    } else {
        PG8_STAGE(PG8_SB(0, 0), cB, voffB); PG8_STAGE_A(PG8_SA(0, 0), cA, 0, false); PG8_STAGE(PG8_SB(0, 1), cB + hstep, voffB); PG8_STAGE_A(PG8_SA(0, 1), cA, 1, false);
        if (wr == 1) PG8_BAR;
        PG8_WAIT_V(4); PG8_BAR;
        PG8_STAGE(PG8_SB(1, 0), cB + kstep, voffB); PG8_STAGE_A(PG8_SA(1, 0), cA + kstep, 0, false); PG8_STAGE(PG8_SB(1, 1), cB + hstep + kstep, voffB);
        PG8_WAIT_V(6); PG8_BAR;
    }
    for (;;) {
        const bool has_next = S.next(ui + 1, nxt);
        const char* nA = (has_next && !Sched::GATHER) ? (const char*)g.A + (size_t)nxt.pm * tstep : cA; const char* nB = has_next ? (const char*)g.Bt + (size_t)nxt.pn * tstep : cB;
        if constexpr (Sched::GATHER) { if (has_next) S.rows(nxt, ui + 1, tid, K, gAn); }
        if constexpr (Epi::LDS_BIAS) E.prefetch(cur, ui & 1, lds, wid, lane);
        for (int t = 0; t < nt; t += 2) {
            const bool last = (t == nt - 2);
            const char* a1 = cA + (size_t)(t + 1) * kstep;
            const char* a2 = last ? nA : cA + (size_t)(t + 2) * kstep; const char* b2 = last ? nB : cB + (size_t)(t + 2) * kstep;
            const char* a3 = a2 + kstep; const char* b3 = b2 + kstep;
            if (last && has_next) S.a_ready(nxt);
            if constexpr (SP2) {
            PG8_LDB(B0, 0, 0); PG8_LDB(B1, 0, 1); PG8_SCHED; PG8_LDA(At, 0, 0); PG8_STAGE_A(PG8_SA(1, 1), a1, 1, false);
            PG8_WAIT_V(8); PG8_WAIT_L(0); PG8_BAR; PG8_MMA(0, 0, At, B0); PG8_MMA(0, 1, At, B1); PG8_BAR; PG8_SCHED;
            PG8_LDA(At, 0, 1); PG8_STAGE(PG8_SB(0, 0), b2, voffB); PG8_STAGE(PG8_SB(0, 1), b2 + hstep, voffB); PG8_STAGE_A(PG8_SA(0, 0), a2, 0, last);
            PG8_WAIT_V(8); PG8_WAIT_L(0); PG8_BAR; PG8_MMA(1, 0, At, B0); PG8_MMA(1, 1, At, B1); PG8_BAR; PG8_SCHED;
            PG8_LDB(B0, 1, 0); PG8_LDB(B1, 1, 1); PG8_SCHED; PG8_LDA(At, 1, 0); PG8_STAGE_A(PG8_SA(0, 1), a2, 1, last);
            PG8_WAIT_V(8); PG8_WAIT_L(0); PG8_BAR; PG8_MMA(0, 0, At, B0); PG8_MMA(0, 1, At, B1); PG8_BAR; PG8_SCHED;
            PG8_LDA(At, 1, 1); PG8_STAGE(PG8_SB(1, 0), b3, voffB); PG8_STAGE(PG8_SB(1, 1), b3 + hstep, voffB); PG8_STAGE_A(PG8_SA(1, 0), a3, 0, last);
            PG8_WAIT_V(8); PG8_WAIT_L(0); PG8_BAR; PG8_MMA(1, 0, At, B0); PG8_MMA(1, 1, At, B1); PG8_BAR; PG8_SCHED;
            } else {
            PG8_LDB(B0, 0, 0); PG8_SCHED; PG8_LDA(At, 0, 0); PG8_STAGE_A(PG8_SA(1, 1), a1, 1, false);
            PG8_WAIT_L(8); PG8_BAR; PG8_WAIT_L(0); PG8_MMA(0, 0, At, B0); PG8_BAR; PG8_SCHED;
            PG8_LDB(B1, 0, 1); PG8_STAGE(PG8_SB(0, 0), b2, voffB);
            PG8_BAR; PG8_WAIT_L(0); PG8_MMA(0, 1, At, B1); PG8_BAR;
            PG8_LDA(At, 0, 1); PG8_STAGE_A(PG8_SA(0, 0), a2, 0, last);
            PG8_BAR; PG8_WAIT_L(0); PG8_MMA(1, 0, At, B0); PG8_BAR; PG8_SCHED;
            PG8_STAGE(PG8_SB(0, 1), b2 + hstep, voffB);
            PG8_WAIT_V(6); PG8_BAR; PG8_MMA(1, 1, At, B1); PG8_BAR;
            PG8_LDB(B0, 1, 0); PG8_SCHED; PG8_LDA(At, 1, 0); PG8_STAGE_A(PG8_SA(0, 1), a2, 1, last);
            PG8_WAIT_L(8); PG8_BAR; PG8_WAIT_L(0); PG8_MMA(0, 0, At, B0); PG8_BAR; PG8_SCHED;
            PG8_LDB(B1, 1, 1); PG8_STAGE(PG8_SB(1, 0), b3, voffB);
            PG8_BAR; PG8_WAIT_L(0); PG8_MMA(0, 1, At, B1); PG8_BAR;
            PG8_LDA(At, 1, 1); PG8_STAGE_A(PG8_SA(1, 0), a3, 0, last);
            PG8_BAR; PG8_WAIT_L(0); PG8_MMA(1, 0, At, B0); PG8_BAR; PG8_SCHED;
            PG8_STAGE(PG8_SB(1, 1), b3 + hstep, voffB);
            PG8_WAIT_V(6); PG8_BAR; PG8_MMA(1, 1, At, B1); PG8_BAR;
            }
        }
        if constexpr (ALIGN_EPI) { if (wr == 0) PG8_BAR; }
        if constexpr (!Epi::AFTER_DRAIN) { if constexpr (Epi::LDS_BIAS) E(acc, cur, wr, wc, fr, fq, lds, ui & 1); else E(acc, cur, wr, wc, fr, fq); S.done(cur); }
        if (!has_next) break;
#pragma unroll
        for (int a = 0; a < 2; ++a)
#pragma unroll
            for (int b = 0; b < 2; ++b)
#pragma unroll
                for (int m = 0; m < 4; ++m)
#pragma unroll
                    for (int n = 0; n < 2; ++n) acc[a][b][m][n] = (f32x4){0.f, 0.f, 0.f, 0.f};
        cur = nxt; cA = nA; cB = nB; ++ui;
        if constexpr (Sched::GATHER) {
#pragma unroll
            for (int h = 0; h < 2; ++h)
#pragma unroll
                for (int i = 0; i < 2; ++i) gA[h][i] = gAn[h][i]; }
        if constexpr (ALIGN_EPI) { if (wr == 1) PG8_BAR; }
    }
    PG8_WAIT_V(0);
    if constexpr (!ALIGN_EPI) { if (wr == 0) PG8_BAR; }
    PG8_BAR;
    if constexpr (Epi::AFTER_DRAIN) { E.fused(acc, cur, wr, wc, fr, fq, lds, wid, lane); S.done(cur); }
#undef PG8_SA
#undef PG8_SB
#undef PG8_STAGE
#undef PG8_STAGE_A
#undef PG8_LDA
#undef PG8_LDB
#undef PG8_MMA
#undef PG8_WAIT_V
#undef PG8_WAIT_L
#undef PG8_BAR
#undef PG8_SCHED
}
}

constexpr int D = 1024, NB = 16, SEQ = 2048, CL = 256, ML = NB * SEQ, MC = NB * CL, MT = ML + MC;
constexpr int NIN = 2992, NINP = 3072, NE = 32, NMODC = 6 * D;
constexpr int PC_AQ = 0, PC_AK = 256, PC_AV = 384, PC_GQ = 512, PC_GZ = 2048, PC_GA = 2560, PC_GB = 2568, PC_CQ = 2576, PC_CKV = 2832, PC_CKR = 2960;
constexpr float EPS = 1e-6f;
constexpr int NSLOT = (MT * 4 / 256 + NE) * 256;
constexpr int NWAVES = 8, NTHR = 512;

constexpr size_t MiB = 1u << 20;
constexpr size_t WS_CTL = 0, CTL_ZERO_BYTES = 1 * MiB;
constexpr size_t WS_MODV = 1 * MiB;
constexpr size_t WS_BGU = 2 * MiB;
constexpr size_t WS_PAIRE = 3 * MiB;
constexpr size_t WS_PAIRR = 4 * MiB;
constexpr size_t WS_PAIRG = 5 * MiB;
constexpr size_t WS_SLOTG = 6 * MiB;
constexpr size_t WS_RWH = 7 * MiB;
constexpr size_t WS_RWL = 7 * MiB + 262144;
constexpr size_t WS_WIN = 8 * MiB;
constexpr size_t WS_WOUT = 20 * MiB;
constexpr size_t WS_WGU = 24 * MiB;
constexpr size_t WS_WDN = 280 * MiB;
constexpr size_t WS_XW = 408 * MiB;
constexpr size_t WS_H = 552 * MiB;
constexpr size_t WS_MIX = 624 * MiB;
constexpr size_t WS_BIG = 696 * MiB;
constexpr size_t WS_P = WS_BIG;
constexpr size_t WS_QA = WS_BIG + 217 * MiB;
constexpr size_t WS_KA = WS_BIG + 253 * MiB;
constexpr size_t WS_VA = WS_BIG + 271 * MiB;
constexpr size_t WS_QM = WS_BIG + 289 * MiB;
constexpr size_t WS_KM = WS_BIG + 343 * MiB;
constexpr size_t WS_VM = WS_BIG + 397 * MiB;
constexpr size_t WS_GW = WS_BIG + 433 * MiB;
constexpr size_t WS_GQD = WS_BIG + 505 * MiB;
constexpr size_t WS_GKDT = WS_BIG + 577 * MiB;
constexpr size_t WS_GQKM = WS_BIG + 649 * MiB;
constexpr size_t WS_GUT = WS_BIG + 685 * MiB;
constexpr size_t WS_GGE = WS_BIG + 829 * MiB;
constexpr size_t WS_OD = WS_BIG + 830 * MiB;
constexpr size_t WS_XS = WS_BIG;
constexpr size_t WS_ACT = WS_BIG + 304 * MiB;
constexpr size_t WS_Y = WS_BIG + 608 * MiB;
constexpr size_t WS_PAIRS = WS_BIG + 974 * MiB;
constexpr size_t WS_TOK = WS_BIG + 975 * MiB;
constexpr size_t WS_TOKE = WS_BIG + 976 * MiB;
constexpr size_t WS_GATEE = WS_BIG + 981 * MiB;
constexpr size_t WS_WUQF = WS_BIG + 986 * MiB;
constexpr size_t WS_WUKVF = WS_BIG + 987 * MiB;
constexpr size_t WS_END = WS_BIG + 988 * MiB;
static_assert((size_t)NSLOT * 2048 <= 304 * MiB && (size_t)MT * 3072 * 2 + 8192 <= 217 * MiB, "ws map");
constexpr int CW_BAR = 4096;
constexpr int CW_CNT = 16384;
constexpr int CW_AQ = 12288;

constexpr int RING_BYTES = 131072, TAB_OFF = RING_BYTES, LDS_BYTES = 155648;
constexpr int MISC_OFF = LDS_BYTES - 256;

#define LAS __attribute__((address_space(3)))
typedef unsigned short bf16;
typedef unsigned v4u __attribute__((ext_vector_type(4)));
typedef unsigned v2u __attribute__((ext_vector_type(2)));
typedef float f32x4 __attribute__((ext_vector_type(4)));
typedef short bf16x8_t __attribute__((ext_vector_type(8)));
#define LDS_WAIT() asm volatile("s_waitcnt lgkmcnt(0)" ::: "memory")
__device__ __forceinline__ unsigned f2bf(float f) { unsigned u = __builtin_bit_cast(unsigned, f); return (u + 0x7fffu + ((u >> 16) & 1u)) >> 16; }
typedef float f32x2_t __attribute__((ext_vector_type(2)));
typedef __bf16 bf16x2_t __attribute__((ext_vector_type(2)));
__device__ __forceinline__ unsigned pk2(float lo, float hi) { const f32x2_t v = {lo, hi}; const bf16x2_t b = __builtin_convertvector(v, bf16x2_t); return __builtin_bit_cast(unsigned, b); }
__device__ __forceinline__ float bf2f(unsigned short b) { return __builtin_bit_cast(float, ((unsigned)b) << 16); }
__device__ __forceinline__ float bflo(unsigned w) { return __builtin_bit_cast(float, w << 16); }
__device__ __forceinline__ float bfhi(unsigned w) { return __builtin_bit_cast(float, w & 0xffff0000u); }
template <int CTRL> __device__ __forceinline__ float dpp_mov(float v) { return __builtin_bit_cast(float, __builtin_amdgcn_update_dpp(0, __builtin_bit_cast(int, v), CTRL, 0xf, 0xf, false)); }
__device__ __forceinline__ float wave_sum(float v) {
    v += dpp_mov<0xB1>(v);
    v += dpp_mov<0x4E>(v);
    v += dpp_mov<0x141>(v);
    v += dpp_mov<0x140>(v);
    v += __shfl_xor(v, 16); v += __shfl_xor(v, 32);
    return v;
}
__device__ __forceinline__ float siluf(float x) { return x * __builtin_amdgcn_rcpf(1.f + __expf(-x)); }

#define XB_TMO      128
#define XB_XCNT(j)  (256  + 64 * (j))
#define XB_XSUB(j)  (1280 + 64 * (j))
#define XB_XGEN(j)  (2304 + 64 * (j))
#define XB_TOP      3328
#define XB_TOPGEN   3392
#define XCD_BAR_WORDS 3456
#define XB_SPIN_CAP (1u << 18)
__device__ __forceinline__ unsigned xb_ld(unsigned* p)              { return __hip_atomic_load(p, __ATOMIC_RELAXED, __HIP_MEMORY_SCOPE_AGENT); }
__device__ __forceinline__ unsigned xb_add(unsigned* p, unsigned v) { return __hip_atomic_fetch_add(p, v, __ATOMIC_RELAXED, __HIP_MEMORY_SCOPE_AGENT); }
__device__ __forceinline__ unsigned xb_xcc_id() { return (unsigned)__builtin_amdgcn_s_getreg((3 << 11) | 20) & 0xFu; }
#define XB_SPIN(cond, bar) do { unsigned _sp = 0; while (cond) { __builtin_amdgcn_s_sleep(1); \
    if ((++_sp & 255u) == 0u) { if (xb_ld(&(bar)[XB_TMO])) break; if (_sp > XB_SPIN_CAP) { atomicAdd(&(bar)[XB_TMO], 1u); break; } } } } while (0)
struct XcdBarrier { unsigned* bar; unsigned x; volatile LAS unsigned* st; };
__device__ __forceinline__ XcdBarrier xcd_barrier_post(unsigned* bar, volatile LAS unsigned* st) {
    XcdBarrier b; b.bar = bar; b.x = xb_xcc_id(); b.st = st;
    if (threadIdx.x == 0) (void)xb_add(&bar[XB_XCNT(b.x)], 1u);
    return b;
}
__device__ __forceinline__ void xcd_barrier_complete(unsigned* bar, unsigned x, unsigned& nloc, unsigned& nx) {
    const unsigned G = gridDim.x * gridDim.y * gridDim.z;
    unsigned sum, cnt, mine, sp = 0u;
    for (;;) {
        sum = 0u; cnt = 0u; mine = 0u;
#pragma unroll
        for (unsigned j = 0; j < 16; ++j) { const unsigned c = xb_ld(&bar[XB_XCNT(j)]); sum += c; cnt += (c > 0u) ? 1u : 0u; mine = (j == x) ? c : mine; }
        if (sum == G) break;
        __builtin_amdgcn_s_sleep(1);
        if ((++sp & 255u) == 0u) { if (xb_ld(&bar[XB_TMO])) break; if (sp > XB_SPIN_CAP) { atomicAdd(&bar[XB_TMO], 1u); break; } }
    }
    nloc = mine > 0u ? mine : 1u; nx = cnt > 0u ? cnt : 1u;
}
__device__ __forceinline__ void xcd_barrier(const XcdBarrier& b) {
    asm volatile("s_waitcnt vmcnt(0)" ::: "memory");
    __syncthreads();
    if (threadIdx.x == 0) {
        unsigned* bar = b.bar;
        __builtin_amdgcn_s_waitcnt(0);
        unsigned nloc = b.st[0], nx = b.st[1];
        if (nloc == 0u) { xcd_barrier_complete(bar, b.x, nloc, nx); b.st[0] = nloc; b.st[1] = nx; }
        const unsigned old = xb_add(&bar[XB_XSUB(b.x)], 1u);
        const unsigned gen = old / nloc;
        if (old + 1u == (gen + 1u) * nloc) {
            __builtin_amdgcn_fence(__ATOMIC_RELEASE, "agent");
            asm volatile("s_waitcnt vmcnt(0)" ::: "memory");
            const unsigned og = xb_add(&bar[XB_TOP], 1u);
            const unsigned tg = og / nx;
            if (og + 1u == (tg + 1u) * nx) xb_add(&bar[XB_TOPGEN], 1u);
            else XB_SPIN(xb_ld(&bar[XB_TOPGEN]) == tg, bar);
            __builtin_amdgcn_fence(__ATOMIC_ACQUIRE, "agent");
            xb_add(&bar[XB_XGEN(b.x)], 1u);
            asm volatile("s_waitcnt vmcnt(0)" ::: "memory");
        } else {
            XB_SPIN(xb_ld(&bar[XB_XGEN(b.x)]) == gen, bar);
            __builtin_amdgcn_fence(__ATOMIC_ACQUIRE, "agent");
            asm volatile("s_waitcnt vmcnt(0)" ::: "memory");
        }
    }
    __syncthreads();
}

namespace pg8 {
struct EpiStoreBf16 {
    static constexpr bool PERM = true, AFTER_DRAIN = false, LDS_BIAS = false;
    bf16_t* O; int ldc;
    __device__ __forceinline__ void operator()(const f32x4 (&acc)[2][2][4][2], const Unit& u, int wr, int wc, int fr, int fq) const {
        const int row0 = u.pm * BM + wr * 64 + fr, col0 = u.pn * BM + wc * 32 + 8 * fq;
#pragma unroll
        for (int ai = 0; ai < 2; ++ai)
#pragma unroll
            for (int m = 0; m < 4; ++m) { bf16_t* rowp = O + (size_t)(row0 + ai * HALF + m * 16) * ldc + col0;
#pragma unroll
                for (int bj = 0; bj < 2; ++bj) { const f32x4 v0 = acc[ai][bj][m][0], v1 = acc[ai][bj][m][1];
                    u32x4 w; w.x = cvt_pk_bf16(v0[0], v0[1]); w.y = cvt_pk_bf16(v0[2], v0[3]); w.z = cvt_pk_bf16(v1[0], v1[1]); w.w = cvt_pk_bf16(v1[2], v1[3]);
                    *(u32x4*)(rowp + bj * HALF) = w; } }
    }
};
struct EpiResid {
    static constexpr bool PERM = false, AFTER_DRAIN = false, LDS_BIAS = false;
    const float* xlat; const float* xctx; const bf16_t* xb; bf16_t* out; const float* modv;
    __device__ __forceinline__ void operator()(const f32x4 (&acc)[2][2][4][2], const Unit& u, int wr, int wc, int fr, int fq) const {
        const int row0 = u.pm * BM + wr * 64 + fr, col0 = u.pn * BM + wc * 32 + 4 * fq;
        const int b = (u.pm < ML / BM) ? (u.pm / (SEQ / BM)) : NB;
        const float* g = modv + (size_t)b * NMODC + 2 * D + col0;
        const float* xin = (u.pm < ML / BM) ? xlat : (xctx - (size_t)ML * D);
        f32x4 gv[2][2];
#pragma unroll
        for (int bj = 0; bj < 2; ++bj)
#pragma unroll
            for (int n = 0; n < 2; ++n) gv[bj][n] = *(const f32x4*)(g + bj * HALF + n * 16);
        typedef unsigned u32x2_ __attribute__((ext_vector_type(2)));
        if (xb) {
#pragma unroll
            for (int ai = 0; ai < 2; ++ai)
#pragma unroll
                for (int mp = 0; mp < 2; ++mp) {
                    u32x2_ rw[2][2][2];
#pragma unroll
                    for (int mm = 0; mm < 2; ++mm) { const size_t off = (size_t)(row0 + ai * HALF + (2 * mp + mm) * 16) * D + col0;
#pragma unroll
                        for (int bj = 0; bj < 2; ++bj)
#pragma unroll
                            for (int n = 0; n < 2; ++n) rw[mm][bj][n] = *(const u32x2_*)(xb + off + bj * HALF + n * 16); }
                    asm volatile("" ::: "memory");
#pragma unroll
                    for (int mm = 0; mm < 2; ++mm) { const int m = 2 * mp + mm; const size_t off = (size_t)(row0 + ai * HALF + m * 16) * D + col0;
#pragma unroll
                        for (int bj = 0; bj < 2; ++bj)
#pragma unroll
                            for (int n = 0; n < 2; ++n) { const unsigned w0 = rw[mm][bj][n].x, w1 = rw[mm][bj][n].y;
                                const f32x4 xi = (f32x4){__builtin_bit_cast(float, w0 << 16), __builtin_bit_cast(float, w0 & 0xffff0000u), __builtin_bit_cast(float, w1 << 16), __builtin_bit_cast(float, w1 & 0xffff0000u)};
                                const f32x4 v = xi + gv[bj][n] * acc[ai][bj][m][n];
                                u32x2_ ow; ow.x = cvt_pk_bf16(v[0], v[1]); ow.y = cvt_pk_bf16(v[2], v[3]);
                                *(u32x2_*)(out + off + bj * HALF + n * 16) = ow; } }
                }
        } else {
#pragma unroll
            for (int ai = 0; ai < 2; ++ai)
#pragma unroll
                for (int mp = 0; mp < 2; ++mp) {
                    f32x4 xr[2][2][2];
#pragma unroll
                    for (int mm = 0; mm < 2; ++mm) { const size_t off = (size_t)(row0 + ai * HALF + (2 * mp + mm) * 16) * D + col0;
#pragma unroll
                        for (int bj = 0; bj < 2; ++bj)
#pragma unroll
                            for (int n = 0; n < 2; ++n) xr[mm][bj][n] = *(const f32x4*)(xin + off + bj * HALF + n * 16); }
                    asm volatile("" ::: "memory");
#pragma unroll
                    for (int mm = 0; mm < 2; ++mm) { const int m = 2 * mp + mm; const size_t off = (size_t)(row0 + ai * HALF + m * 16) * D + col0;
#pragma unroll
                        for (int bj = 0; bj < 2; ++bj)
#pragma unroll
                            for (int n = 0; n < 2; ++n) { const f32x4 v = xr[mm][bj][n] + gv[bj][n] * acc[ai][bj][m][n];
                                u32x2_ ow; ow.x = cvt_pk_bf16(v[0], v[1]); ow.y = cvt_pk_bf16(v[2], v[3]);
                                *(u32x2_*)(out + off + bj * HALF + n * 16) = ow; } }
                }
        }
    }
};
template <bool GATHER_> struct MoeOrderT {
    static constexpr bool GATHER = GATHER_;
    const LAS int* tstart; int TR, nsub, G, c; const int* tok;
    __device__ __forceinline__ bool next(int i, Unit& u) const {
        int rt, pl;
        if ((G & 7) == 0) { const int x = c & 7, j = c >> 3, bpx = G >> 3; const int r0 = (TR * x) >> 3, r1 = (TR * (x + 1)) >> 3; const int m = i * bpx + j;
            rt = r0 + m / nsub; pl = m % nsub; if (rt >= r1) return false; }
        else { const long L = (long)i * G + c; rt = (int)(L / nsub); pl = (int)(L % nsub); if (rt >= TR) return false; }
        int e = 0, hi = NE;
#pragma unroll
        for (int st = 0; st < 5; ++st) { const int mid = (e + hi) >> 1; const bool le = __builtin_amdgcn_readfirstlane(tstart[mid]) <= rt; e = le ? mid : e; hi = le ? hi : mid; }
        e = __builtin_amdgcn_readfirstlane(e);
        u.pm = rt; u.pn = e * nsub + pl; return true;
    }
    static constexpr int MAXU = 22;
    const LAS unsigned short* ltab;
    __device__ __forceinline__ void preload(LAS unsigned short* tab, int tid) const {
        Unit u;
        for (int ord = 0; ord < MAXU && next(ord, u); ++ord) if (tid < BM) { const int e = u.pn / nsub, rank = (u.pm - tstart[e]) * BM + tid;
            tab[ord * BM + tid] = (rank < tstart[33 + e]) ? (unsigned short)tok[(size_t)e * MT + rank] : (unsigned short)0; }
    }
    __device__ __forceinline__ void rows(const Unit& u, int ord, int tid, int K, unsigned (&out)[2][2]) const {
#pragma unroll
        for (int i = 0; i < 2; ++i) { int R, C; stage_rc(tid * 16 + i * 8192, R, C);
#pragma unroll
            for (int h = 0; h < 2; ++h) out[h][i] = (unsigned)ltab[ord * BM + h * HALF + R] * (unsigned)(K * 2) + (unsigned)C * 2u; }
    }
    __device__ __forceinline__ void a_ready(const Unit&) const {}
    __device__ __forceinline__ void done(const Unit&) const {}
};
constexpr int EBUF_OFF = TAB_OFF + 512 + 22 * 512;
struct EpiSwiglu {
    static constexpr bool PERM = true, AFTER_DRAIN = false, LDS_BIAS = true;
    bf16_t* O; const float* bias;
    __device__ __forceinline__ void prefetch(const Unit& u, int par, PG8_LAS unsigned char* lds, int wid, int lane) const {
        if (wid == 0) __builtin_amdgcn_global_load_lds((const unsigned*)(bias + (size_t)(u.pn >> 3) * 2048 + (u.pn & 7) * 256 + lane * 4), (PG8_LAS unsigned*)(lds + EBUF_OFF + par * 2048), 16, 0, 0);
    }
    __device__ __forceinline__ void operator()(const f32x4 (&acc)[2][2][4][2], const Unit& u, int wr, int wc, int fr, int fq, PG8_LAS unsigned char* lds, int par) const {
        const int pl = u.pn & 7;
        const int row0 = u.pm * BM + wr * 64 + fr, c0 = wc * 32 + 8 * fq;
        const PG8_LAS float* bp = (const PG8_LAS float*)(lds + EBUF_OFF + par * 2048) + c0;
        f32x4 bg[2], bl[2];
#pragma unroll
        for (int n = 0; n < 2; ++n) { bg[n] = *(const PG8_LAS f32x4*)(bp + 4 * n); bl[n] = *(const PG8_LAS f32x4*)(bp + HALF + 4 * n); }
#pragma unroll
        for (int ai = 0; ai < 2; ++ai)
#pragma unroll
            for (int m = 0; m < 4; ++m) { bf16_t* rowp = O + (size_t)(row0 + ai * HALF + m * 16) * 1024 + pl * 128 + c0;
                float r[8];
#pragma unroll
                for (int n = 0; n < 2; ++n)
#pragma unroll
                    for (int j = 0; j < 4; ++j) { const float gl = fminf(acc[ai][0][m][n][j] + bg[n][j], 7.0f);
                        const float li = fminf(fmaxf(acc[ai][1][m][n][j] + bl[n][j], -7.0f), 7.0f);
                        r[n * 4 + j] = gl * __builtin_amdgcn_rcpf(1.f + __expf(-1.702f * gl)) * (li + 1.f); }
                u32x4 w; w.x = cvt_pk_bf16(r[0], r[1]); w.y = cvt_pk_bf16(r[2], r[3]); w.z = cvt_pk_bf16(r[4], r[5]); w.w = cvt_pk_bf16(r[6], r[7]);
                *(u32x4*)rowp = w; }
    }
};
struct EpiDown {
    static constexpr bool PERM = true, AFTER_DRAIN = false, LDS_BIAS = true;
    bf16_t* O; const float* bias; const float* slotg; const PG8_LAS int* tstart;
    __device__ __forceinline__ void prefetch(const Unit& u, int par, PG8_LAS unsigned char* lds, int wid, int lane) const {
        if (wid == 0) __builtin_amdgcn_global_load_lds((const unsigned*)(bias + (size_t)(u.pn >> 2) * 1024 + (u.pn & 3) * 256 + lane * 4), (PG8_LAS unsigned*)(lds + EBUF_OFF + par * 2048), 16, 0, 0);
        if (wid == 1) { const int e = u.pn >> 2; __builtin_amdgcn_global_load_lds((const unsigned*)(slotg + (size_t)e * MT + (size_t)(u.pm - tstart[e]) * BM + lane * 4), (PG8_LAS unsigned*)(lds + EBUF_OFF + par * 2048 + 1024), 16, 0, 0); }
    }
    __device__ __forceinline__ void operator()(const f32x4 (&acc)[2][2][4][2], const Unit& u, int wr, int wc, int fr, int fq, PG8_LAS unsigned char* lds, int par) const {
        const int pl = u.pn & 3;
        const int rl0 = wr * 64 + fr, cl0 = wc * 32 + 8 * fq; const int row0 = u.pm * BM + rl0, col0 = pl * BM + cl0;
        const PG8_LAS float* eb = (const PG8_LAS float*)(lds + EBUF_OFF + par * 2048);
        f32x4 bv[2][2];
#pragma unroll
        for (int bj = 0; bj < 2; ++bj)
#pragma unroll
            for (int n = 0; n < 2; ++n) bv[bj][n] = *(const PG8_LAS f32x4*)(eb + cl0 + bj * HALF + 4 * n);
#pragma unroll
        for (int ai = 0; ai < 2; ++ai)
#pragma unroll
            for (int m = 0; m < 4; ++m) { const int row = row0 + ai * HALF + m * 16; const float gt = eb[256 + rl0 + ai * HALF + m * 16]; bf16_t* rowp = O + (size_t)row * 1024 + col0;
#pragma unroll
                for (int bj = 0; bj < 2; ++bj) { const f32x4 v0 = (acc[ai][bj][m][0] + bv[bj][0]) * gt, v1 = (acc[ai][bj][m][1] + bv[bj][1]) * gt;
                    u32x4 w; w.x = cvt_pk_bf16(v0[0], v0[1]); w.y = cvt_pk_bf16(v0[2], v0[3]); w.z = cvt_pk_bf16(v1[0], v1[1]); w.w = cvt_pk_bf16(v1[2], v1[3]);
                    *(u32x4*)(rowp + bj * HALF) = w; } }
    }
};
}

template <int DQK>
__device__ __forceinline__ void attn_block(LAS unsigned char* lds, const bf16* Qb, int qpitch, const bf16* K, const bf16* Vt, int tA0, int tA1, int tB0, int tB1,
                                           int q0, bool masked, float sc_l2, bool has_sink, float sink_l2, bf16* Ob, int tid) {
    constexpr int NKS = DQK / 32, CPR = DQK / 8  , KP = DQK * 2 + 32  , VP = 160  , KBYTES = 64 * KP, STAGE = KBYTES + 64 * VP;
    const int lane = tid & 63, wv = __builtin_amdgcn_readfirstlane(tid >> 6), r = lane & 15, g = lane >> 4;
    const bf16* Q = Qb + (size_t)(32 * wv) * qpitch; bf16* O = Ob + (size_t)(32 * wv) * D; const int t0 = q0 + 32 * wv;
    bf16x8_t qf[2][NKS];
#pragma unroll
    for (int qb = 0; qb < 2; ++qb)
#pragma unroll
        for (int ks = 0; ks < NKS; ++ks) qf[qb][ks] = *(const bf16x8_t*)(Q + (size_t)(16 * qb + r) * qpitch + 32 * ks + 8 * g);
    f32x4 oacc[2][4];
#pragma unroll
    for (int qb = 0; qb < 2; ++qb)
#pragma unroll
        for (int nb = 0; nb < 4; ++nb) oacc[qb][nb] = (f32x4){0.f, 0.f, 0.f, 0.f};
    float mrun[2] = {-INFINITY, -INFINITY}, lrun[2] = {0.f, 0.f};
    const int kr0 = tid / CPR, kc0 = tid % CPR, kr1 = (tid + 512) / CPR, kc1 = (tid + 512) % CPR, vr = tid >> 3, vc = tid & 7;
    const bool two = (CPR * 64 > 512) && (tid + 512 < CPR * 64);
    v4u sk0, sk1 = (v4u){0u, 0u, 0u, 0u}, sv;
    const unsigned ko0 = (unsigned)(kr0 * DQK + kc0 * 8) * 2u, ko1 = (unsigned)(kr1 * DQK + kc1 * 8) * 2u, vo = (unsigned)(vr * 2304 + vc * 8) * 2u;
#define AB_GLOAD(kt_) do { const char* kb_ = (const char*)K + (size_t)((kt_) * 64) * (DQK * 2); const char* vb_ = (const char*)Vt + (size_t)((kt_) * 64) * 2; \
        sk0 = *(const v4u*)(kb_ + ko0); if (two) sk1 = *(const v4u*)(kb_ + ko1); sv = *(const v4u*)(vb_ + vo); } while (0)
#define AB_LSTORE(buf_) do { LAS unsigned char* sb_ = lds + (buf_) * STAGE; *(LAS v4u*)(sb_ + kr0 * KP + kc0 * 16) = sk0; if (two) *(LAS v4u*)(sb_ + kr1 * KP + kc1 * 16) = sk1; \
        *(LAS v4u*)(sb_ + KBYTES + vr * VP + vc * 16) = sv; } while (0)
    int kt = tA0, buf = 0;
    if (kt >= tA1) kt = tB0;
    if (kt < tB1) { AB_GLOAD(kt); AB_LSTORE(0); }
    __syncthreads();
    while (kt < tB1) {
        const int ktn = (kt + 1 == tA1) ? tB0 : kt + 1;
        if (ktn < tB1) AB_GLOAD(ktn);
        const int key0 = kt * 64;
        const bool live = !masked || key0 < CL || !((key0 - CL) + 63 < t0 - 128 || (key0 - CL) > t0 + 31 + 128);
        if (live) {
            const LAS unsigned char* sb = lds + buf * STAGE;
            bf16x8_t kf[4][NKS], vf[2][4];
#pragma unroll
            for (int blk = 0; blk < 4; ++blk)
#pragma unroll
                for (int ks = 0; ks < NKS; ++ks) kf[blk][ks] = *(const LAS bf16x8_t*)(sb + (16 * blk + r) * KP + 64 * ks + 16 * g);
#pragma unroll
            for (int sub = 0; sub < 2; ++sub)
#pragma unroll
                for (int nb = 0; nb < 4; ++nb) vf[sub][nb] = *(const LAS bf16x8_t*)(sb + KBYTES + (16 * nb + r) * VP + 64 * sub + 16 * g);
#pragma unroll
            for (int qb = 0; qb < 2; ++qb) {
                f32x4 s[4];
#pragma unroll
                for (int blk = 0; blk < 4; ++blk) { s[blk] = (f32x4){0.f, 0.f, 0.f, 0.f};
#pragma unroll
                    for (int ks = 0; ks < NKS; ++ks) s[blk] = __builtin_amdgcn_mfma_f32_16x16x32_bf16(kf[blk][ks], qf[qb][ks], s[blk], 0, 0, 0); }
                float tmax = -INFINITY;
#pragma unroll
                for (int blk = 0; blk < 4; ++blk)
#pragma unroll
                    for (int i = 0; i < 4; ++i) { float x = s[blk][i] * sc_l2;
                        if (masked) { const int kk = key0 + 16 * blk + 4 * g + i; const int dj = (t0 + 16 * qb + r) - (kk - CL); if (kk >= CL && (dj > 128 || dj < -128)) x = -INFINITY; }
                        s[blk][i] = x; tmax = fmaxf(tmax, x); }
                tmax = fmaxf(tmax, __shfl_xor(tmax, 16)); tmax = fmaxf(tmax, __shfl_xor(tmax, 32));
                const bool rebase = __any(tmax > mrun[qb] + 8.0f);
                const float mn = rebase ? fmaxf(mrun[qb], tmax) : mrun[qb];
                float p[16], ps = 0.f;
#pragma unroll
                for (int blk = 0; blk < 4; ++blk)
#pragma unroll
                    for (int i = 0; i < 4; ++i) { p[blk * 4 + i] = __builtin_amdgcn_exp2f(s[blk][i] - mn); ps += p[blk * 4 + i]; }
                if (rebase) { const float corr = __builtin_amdgcn_exp2f(mrun[qb] - mn); lrun[qb] *= corr;
#pragma unroll
                    for (int nb = 0; nb < 4; ++nb) oacc[qb][nb] = oacc[qb][nb] * corr; }
                lrun[qb] += ps; mrun[qb] = mn;
                bf16x8_t pb[2];
#pragma unroll
                for (int sub = 0; sub < 2; ++sub) { v4u pw; pw.x = pk2(p[8 * sub], p[8 * sub + 1]); pw.y = pk2(p[8 * sub + 2], p[8 * sub + 3]); pw.z = pk2(p[8 * sub + 4], p[8 * sub + 5]); pw.w = pk2(p[8 * sub + 6], p[8 * sub + 7]);
                    pb[sub] = __builtin_bit_cast(bf16x8_t, pw); }
#pragma unroll
                for (int nb = 0; nb < 4; ++nb) {
                    oacc[qb][nb] = __builtin_amdgcn_mfma_f32_16x16x32_bf16(vf[0][nb], pb[0], oacc[qb][nb], 0, 0, 0);
                    oacc[qb][nb] = __builtin_amdgcn_mfma_f32_16x16x32_bf16(vf[1][nb], pb[1], oacc[qb][nb], 0, 0, 0); }
            }
        }
        if (ktn < tB1) AB_LSTORE(buf ^ 1);
        __syncthreads();
        kt = ktn; buf ^= 1;
    }
#undef AB_GLOAD
#undef AB_LSTORE
#pragma unroll
    for (int qb = 0; qb < 2; ++qb) {
        float l = lrun[qb]; l += __shfl_xor(l, 16); l += __shfl_xor(l, 32);
        float fin = 1.f;
        if (has_sink) { const float mn = fmaxf(mrun[qb], sink_l2); const float corr = __builtin_amdgcn_exp2f(mrun[qb] - mn); l = l * corr + __builtin_amdgcn_exp2f(sink_l2 - mn); fin = corr; }
        const float inv = fin / l;
#pragma unroll
        for (int nb = 0; nb < 4; ++nb) { const f32x4 o = oacc[qb][nb] * inv; v2u w; w.x = pk2(o.x, o.y); w.y = pk2(o.z, o.w);
            *(v2u*)(O + (size_t)(16 * qb + r) * D + 16 * nb + 4 * g) = w; }
    }
}

struct Args { const float* in[29]; float* out; unsigned char* ws; int ph_lo, ph_hi, rep_mask, pad; };
enum { I_X = 0, I_C, I_CTX, I_CCTX, I_WMOD, I_BMOD, I_NORM1, I_NORM2, I_WIN, I_WOUT, I_SWAQN, I_SWAKN, I_SINK, I_CONV, I_ALOG, I_DTB, I_GONORM,
       I_QANORM, I_WUQ, I_KVANORM, I_WUKV, I_MQN, I_MKN, I_RW, I_RB, I_WGU, I_BGU, I_WDN, I_BDN };

template <int MODE> __device__ __forceinline__ void tr_item(const float* W, int K, int N, bf16* WT, LAS float* scr, int item, int nblk, int lane) {
    const int kb = item / nblk, nb = item % nblk, k0 = 64 * kb, n0 = 64 * nb;
    const int nsrc = n0 + lane;
    float wv[64];
#pragma unroll
    for (int i = 0; i < 64; ++i) wv[i] = (nsrc < N) ? W[(size_t)(k0 + i) * N + nsrc] : 0.f;
#pragma unroll
    for (int i = 0; i < 64; ++i) scr[i * 65 + lane] = wv[i];
    LDS_WAIT(); asm volatile("" ::: "memory");
    const int c = lane & 7;
#pragma unroll
    for (int j = 0; j < 8; ++j) { const int n = (lane >> 3) + 8 * j; const LAS float* s = scr + (8 * c) * 65 + n;
        v4u o; o.x = pk2(s[0 * 65], s[1 * 65]); o.y = pk2(s[2 * 65], s[3 * 65]); o.z = pk2(s[4 * 65], s[5 * 65]); o.w = pk2(s[6 * 65], s[7 * 65]);
        const int col = n0 + n; const int drow = (MODE == 1) ? (((col >> 1) >> 7) * 256 + (col & 1) * 128 + ((col >> 1) & 127)) : col;
        *(v4u*)(WT + (size_t)drow * K + k0 + 8 * c) = o; }
    LDS_WAIT(); asm volatile("" ::: "memory");
}

__device__ __forceinline__ void norm_mod_row(const f32x4 (&v)[4], const float* gain, const float* shift, const float* scale, bf16* orow, int lane) {
    f32x4 g[4], sh[4], sc[4];
#pragma unroll
    for (int j = 0; j < 4; ++j) { const int idx = j * 256 + lane * 4; g[j] = *(const f32x4*)(gain + idx); sh[j] = *(const f32x4*)(shift + idx); sc[j] = *(const f32x4*)(scale + idx); }
    asm volatile("" ::: "memory");
    float ss = 0.f;
#pragma unroll
    for (int j = 0; j < 4; ++j) ss += (v[j].x * v[j].x + v[j].y * v[j].y) + (v[j].z * v[j].z + v[j].w * v[j].w);
    const float rstd = rsqrtf(wave_sum(ss) * (1.f / D) + EPS);
#pragma unroll
    for (int j = 0; j < 4; ++j) { const int idx = j * 256 + lane * 4;
        const f32x4 y = v[j] * rstd * g[j] * (sc[j] + 1.f) + sh[j];
        v2u o; o.x = pk2(y.x, y.y); o.y = pk2(y.z, y.w); *(v2u*)(orow + idx) = o; }
}

__device__ __forceinline__ void norm_mod_row_pre(const f32x4 (&v)[4], const f32x4 (&g)[4], const f32x4 (&sh)[4], const f32x4 (&sc)[4], bf16* orow, int lane) {
    float ss = 0.f;
#pragma unroll
    for (int j = 0; j < 4; ++j) ss += (v[j].x * v[j].x + v[j].y * v[j].y) + (v[j].z * v[j].z + v[j].w * v[j].w);
    const float rstd = rsqrtf(wave_sum(ss) * (1.f / D) + EPS);
#pragma unroll
    for (int j = 0; j < 4; ++j) { const int idx = j * 256 + lane * 4;
        const f32x4 y = v[j] * rstd * g[j] * (sc[j] + 1.f) + sh[j];
        v2u o; o.x = pk2(y.x, y.y); o.y = pk2(y.z, y.w); *(v2u*)(orow + idx) = o; }
}

template <int DQK>
__device__ __forceinline__ void attn_unit_mfma(const bf16* Q, int qpitch, const bf16* K, const bf16* Vt, int kta0, int kta1, int ktb0, int ktb1,
                                               int t0, bool masked, float sc_l2, bool has_sink, float sink_l2, bf16* O, int lane) {
    constexpr int NKS = DQK / 32;
    const int r = lane & 15, g = lane >> 4;
    bf16x8_t qf[2][NKS];
#pragma unroll
    for (int qb = 0; qb < 2; ++qb)
#pragma unroll
        for (int ks = 0; ks < NKS; ++ks) qf[qb][ks] = *(const bf16x8_t*)(Q + (size_t)(16 * qb + r) * qpitch + 32 * ks + 8 * g);
    f32x4 oacc[2][4];
#pragma unroll
    for (int qb = 0; qb < 2; ++qb)
#pragma unroll
        for (int nb = 0; nb < 4; ++nb) oacc[qb][nb] = (f32x4){0.f, 0.f, 0.f, 0.f};
    float mrun[2] = {-INFINITY, -INFINITY}, lrun[2] = {0.f, 0.f};
    bf16x8_t nkf[2][NKS], nvf[4];
#define ATT_LOAD(kt_) do { const int key0_ = (kt_) * 32; \
        _Pragma("unroll") for (int blk = 0; blk < 2; ++blk) _Pragma("unroll") for (int ks = 0; ks < NKS; ++ks) nkf[blk][ks] = *(const bf16x8_t*)(K + (size_t)(key0_ + 16 * blk + r) * DQK + 32 * ks + 8 * g); \
        _Pragma("unroll") for (int nb = 0; nb < 4; ++nb) nvf[nb] = *(const bf16x8_t*)(Vt + (size_t)(16 * nb + r) * 2304 + key0_ + 8 * g); } while (0)
    if (kta0 < ktb1) ATT_LOAD(kta0);
    for (int kt = kta0; kt < ktb1;) {
        const int ktn = (kt + 1 == kta1) ? ktb0 : kt + 1;
        const int key0 = kt * 32;
        bf16x8_t kf[2][NKS], vf[4];
#pragma unroll
        for (int blk = 0; blk < 2; ++blk)
#pragma unroll
            for (int ks = 0; ks < NKS; ++ks) kf[blk][ks] = nkf[blk][ks];
#pragma unroll
        for (int nb = 0; nb < 4; ++nb) vf[nb] = nvf[nb];
        if (ktn < ktb1) ATT_LOAD(ktn);
#pragma unroll
        for (int qb = 0; qb < 2; ++qb) {
            f32x4 s[2];
#pragma unroll
            for (int blk = 0; blk < 2; ++blk) { s[blk] = (f32x4){0.f, 0.f, 0.f, 0.f};
#pragma unroll
                for (int ks = 0; ks < NKS; ++ks) s[blk] = __builtin_amdgcn_mfma_f32_16x16x32_bf16(kf[blk][ks], qf[qb][ks], s[blk], 0, 0, 0); }
            float tmax = -INFINITY;
#pragma unroll
            for (int blk = 0; blk < 2; ++blk)
#pragma unroll
                for (int i = 0; i < 4; ++i) { float x = s[blk][i] * sc_l2;
                    if (masked) { const int kk = key0 + 16 * blk + 4 * g + i; const int dj = (t0 + 16 * qb + r) - (kk - CL); if (kk >= CL && (dj > 128 || dj < -128)) x = -INFINITY; }
                    s[blk][i] = x; tmax = fmaxf(tmax, x); }
            tmax = fmaxf(tmax, __shfl_xor(tmax, 16)); tmax = fmaxf(tmax, __shfl_xor(tmax, 32));
            const float mn = fmaxf(mrun[qb], tmax);
            const float corr = __builtin_amdgcn_exp2f(mrun[qb] - mn);
            float p[8], ps = 0.f;
#pragma unroll
            for (int blk = 0; blk < 2; ++blk)
#pragma unroll
                for (int i = 0; i < 4; ++i) { p[blk * 4 + i] = __builtin_amdgcn_exp2f(s[blk][i] - mn); ps += p[blk * 4 + i]; }
            lrun[qb] = lrun[qb] * corr + ps; mrun[qb] = mn;
            v4u pw; pw.x = pk2(p[0], p[1]); pw.y = pk2(p[2], p[3]); pw.z = pk2(p[4], p[5]); pw.w = pk2(p[6], p[7]);
            const bf16x8_t pb = __builtin_bit_cast(bf16x8_t, pw);
#pragma unroll
            for (int nb = 0; nb < 4; ++nb) { oacc[qb][nb] = oacc[qb][nb] * corr; oacc[qb][nb] = __builtin_amdgcn_mfma_f32_16x16x32_bf16(vf[nb], pb, oacc[qb][nb], 0, 0, 0); }
        }
        kt = ktn;
    }
#undef ATT_LOAD
#pragma unroll
    for (int qb = 0; qb < 2; ++qb) {
        float l = lrun[qb]; l += __shfl_xor(l, 16); l += __shfl_xor(l, 32);
        float fin = 1.f;
        if (has_sink) { const float mn = fmaxf(mrun[qb], sink_l2); const float corr = __builtin_amdgcn_exp2f(mrun[qb] - mn); l = l * corr + __builtin_amdgcn_exp2f(sink_l2 - mn); fin = corr; }
        const float inv = fin / l;
#pragma unroll
        for (int nb = 0; nb < 4; ++nb) { const f32x4 o = oacc[qb][nb] * inv; v2u w; w.x = pk2(o.x, o.y); w.y = pk2(o.z, o.w);
            *(v2u*)(O + (size_t)(16 * qb + r) * D + 16 * nb + 4 * g) = w; }
    }
}

constexpr int KT = CL + SEQ;
#define OPAQ(p) asm volatile("" : "+s"(p))
#ifndef PROBE_REP
#define PROBE_REP 0
#endif
#define REPEAT(cls) for (int rep_ = 0, nrep_ = 1 + ((rep_mask >> (cls)) & 1); rep_ < nrep_; ++rep_)
#define WSP(T, name, off) T* name = (T*)(wsb + (off))
#define CAS __attribute__((address_space(4)))
typedef const float* cfp_t;
#define PHASE_VIEW() const CAS unsigned char* kap = (const CAS unsigned char*)__builtin_amdgcn_kernarg_segment_ptr(); OPAQ(kap); \
    const CAS cfp_t* inp = (const CAS cfp_t*)kap; unsigned char* wsb = *(unsigned char* const CAS*)(kap + offsetof(Args, ws)); (void)inp; (void)wsb; \
    unsigned ones_ = ~0u; OPAQ(ones_); int tid = wave0 * 64 + (int)__builtin_amdgcn_mbcnt_hi(ones_, __builtin_amdgcn_mbcnt_lo(ones_, 0u)); asm volatile("" : "+v"(tid)); int bid = bid0; OPAQ(bid); int G = G0; OPAQ(G); \
    const int lane = tid & 63, wave = __builtin_amdgcn_readfirstlane(tid >> 6), gw = bid * NWAVES + wave, NGW = G * NWAVES; (void)lane; (void)gw; (void)NGW
__global__ void __launch_bounds__(NTHR, 2) fwd(Args args) {
    extern __shared__ __attribute__((aligned(16))) unsigned char lds_raw[];
    LAS unsigned char* lds = (LAS unsigned char*)lds_raw;
    volatile LAS unsigned* MISC = (volatile LAS unsigned*)(lds + MISC_OFF);
    const int wave0 = __builtin_amdgcn_readfirstlane((int)threadIdx.x >> 6), bid0 = blockIdx.x, G0 = gridDim.x;

    if (threadIdx.x < 64) MISC[threadIdx.x] = 0u;
    __syncthreads();
    const int lo = args.ph_lo, hi = args.ph_hi, rep_mask = args.rep_mask;
    XcdBarrier bar; bar.bar = (unsigned*)(args.ws + WS_CTL) + CW_BAR; bar.x = 0; bar.st = nullptr;
    if (hi - lo > 1) bar = xcd_barrier_post((unsigned*)(args.ws + WS_CTL) + CW_BAR, MISC + 8);
#define IN(k) (lo <= (k) && (k) < hi)
#define SEAM(k) do { if (IN(k) && IN((k) + 1)) { for (int br_ = 0, nbr_ = 1 + ((rep_mask >> 16) & 1); br_ < nbr_; ++br_) { XcdBarrier b2 = bar; OPAQ(b2.bar); xcd_barrier(b2); } } } while (0)

    if (IN(0)) REPEAT(0) {
        PHASE_VIEW();
        WSP(float, MODV, WS_MODV); WSP(float, BGU, WS_BGU); WSP(bf16, WIN, WS_WIN); WSP(bf16, WOUT, WS_WOUT); WSP(bf16, WGU, WS_WGU); WSP(bf16, WDN, WS_WDN);
        for (int item = bid; item < 2 * 96; item += G) {
            const int l = item / 96, n0 = (item % 96) * 64;
            LAS float* sil = (LAS float*)lds;
            LAS float* red = (LAS float*)(lds + 69632);
            __syncthreads();
            for (int i = tid; i < 17 * 1024; i += NTHR) { const int r = i >> 10, k = i & 1023; const float cv = (r < 16) ? inp[I_C][r * 1024 + k] : inp[I_CCTX][k]; sil[i] = siluf(cv); }
            __syncthreads();
            float acc[17];
#pragma unroll
            for (int r = 0; r < 17; ++r) acc[r] = 0.f;
            const float* wp = inp[I_WMOD] + ((size_t)l * 1024 + wave * 128) * NMODC + n0 + lane;
#pragma unroll 1
            for (int k0 = 0; k0 < 128; k0 += 32) { float wv[32];
#pragma unroll
                for (int k = 0; k < 32; ++k) wv[k] = wp[(size_t)(k0 + k) * NMODC];
#pragma unroll
                for (int k = 0; k < 32; ++k)
#pragma unroll
                    for (int r = 0; r < 17; ++r) acc[r] += sil[r * 1024 + wave * 128 + k0 + k] * wv[k]; }
#pragma unroll
            for (int r = 0; r < 17; ++r) red[(wave * 17 + r) * 64 + lane] = acc[r];
            __syncthreads();
            for (int i = tid; i < 17 * 64; i += NTHR) { const int r = i >> 6, cix = i & 63; float s = inp[I_BMOD][l * NMODC + n0 + cix];
#pragma unroll
                for (int w = 0; w < 8; ++w) s += red[(w * 17 + r) * 64 + cix];
                MODV[((size_t)l * 17 + r) * NMODC + n0 + cix] = s; }
        }
        __syncthreads();
        {
            LAS float* scr = (LAS float*)(lds + wave * 16896);
            constexpr int I_GU1 = 16 * 32, I_DN1 = 16 * 16, I_IN1 = 16 * 48, I_OUT1 = 16 * 16;
            constexpr int N_GU = 64 * I_GU1, N_DN = 64 * I_DN1, N_IN = 2 * I_IN1, N_OUT = 2 * I_OUT1;
            for (int it = gw; it < N_GU + N_DN + N_IN + N_OUT; it += NGW) {
                int r = it;
                if (r < N_GU) { const int mtx = r / I_GU1; tr_item<1>(inp[I_WGU] + (size_t)mtx * 1024 * 2048, 1024, 2048, WGU + (size_t)mtx * 2048 * 1024, scr, r % I_GU1, 32, lane); continue; } r -= N_GU;
                if (r < N_DN) { const int mtx = r / I_DN1; tr_item<0>(inp[I_WDN] + (size_t)mtx * 1024 * 1024, 1024, 1024, WDN + (size_t)mtx * 1024 * 1024, scr, r % I_DN1, 16, lane); continue; } r -= N_DN;
                if (r < N_IN) { const int mtx = r / I_IN1; tr_item<0>(inp[I_WIN] + (size_t)mtx * 1024 * NIN, 1024, NIN, WIN + (size_t)mtx * NINP * 1024, scr, r % I_IN1, 48, lane); continue; } r -= N_IN;
                { const int mtx = r / I_OUT1; tr_item<0>(inp[I_WOUT] + (size_t)mtx * 1024 * 1024, 1024, 1024, WOUT + (size_t)mtx * 1024 * 1024, scr, r % I_OUT1, 16, lane); }
            }
        }
        { WSP(bf16, RWH, WS_RWH); WSP(bf16, RWL, WS_RWL);
          for (int i = bid * NTHR + tid; i < 2 * 32 * 1024; i += G * NTHR) { const int k = i & 1023, e = (i >> 10) & 31, l2 = i >> 15;
              const float w = inp[I_RW][((size_t)l2 * 1024 + k) * 32 + e]; const unsigned hi16 = f2bf(w); RWH[i] = (bf16)hi16; RWL[i] = (bf16)f2bf(w - __builtin_bit_cast(float, hi16 << 16)); } }
        { WSP(bf16, WUQF, WS_WUQF); WSP(bf16, WUKVF, WS_WUKVF);
          for (int i = bid * NTHR + tid; i < 2 * 384 * 256; i += G * NTHR) { const int k = i & 255, n = (i >> 8) % 384, l2 = i / (384 * 256);
              WUQF[i] = (bf16)f2bf(inp[I_WUQ][((size_t)l2 * 256 + k) * 384 + n] * inp[I_QANORM][l2 * 256 + k]); }
          for (int i = bid * NTHR + tid; i < 2 * 512 * 128; i += G * NTHR) { const int k = i & 127, n = (i >> 7) & 511, l2 = i >> 16;
              WUKVF[i] = (bf16)f2bf(inp[I_WUKV][((size_t)l2 * 128 + k) * 512 + n] * inp[I_KVANORM][l2 * 128 + k]); } }
        for (int i = bid * NTHR + tid; i < 2 * 32 * 2048; i += G * NTHR) { const int np = i & 2047, le = i >> 11; const int pn = np >> 8, bj = (np >> 7) & 1, j = np & 127;
            BGU[i] = inp[I_BGU][(size_t)le * 2048 + 2 * (128 * pn + j) + bj]; }
    }
    SEAM(0);

    if (IN(1)) {
        PHASE_VIEW();
        WSP(float, MODV, WS_MODV); WSP(bf16, H, WS_H);
        for (int row = gw; row < MT; row += NGW) {
            const float* xr = (row < ML) ? inp[I_X] + (size_t)row * D : inp[I_CTX] + (size_t)(row - ML) * D;
            const int b = (row < ML) ? row / SEQ : NB;
            f32x4 v[4];
#pragma unroll
            for (int j = 0; j < 4; ++j) v[j] = *(const f32x4*)(xr + j * 256 + lane * 4);
            const float* mv = MODV + (size_t)b * NMODC;
            norm_mod_row(v, inp[I_NORM1], mv + 0 * D, mv + 1 * D, H + (size_t)row * D, lane);
        }
    }
    SEAM(1);

    constexpr int NPL = 9;
    for (int l = 0; l < 2; ++l) {
        const int pb = 2 + l * NPL;
        const int MROWS = (l == 0) ? MT : ML;

        if (IN(pb + 0)) REPEAT(2) {
            PHASE_VIEW();
            WSP(bf16, H, WS_H); WSP(bf16, WIN, WS_WIN); WSP(bf16, P, WS_P);
            pg8::Gemm g{H, WIN + (size_t)l * NINP * 1024, MT, NINP, 1024}; pg8::StaticOrder S; S.init(MT, NINP, G, bid);
            pg8::EpiStoreBf16 E{P, NINP};
            pg8::gemm_phase<pg8::EpiStoreBf16, pg8::StaticOrder, true, true>(lds, g, S, E, wave0, 1 + ((rep_mask >> 22) & 1));
        }
        SEAM(pb + 0);

        if (IN(pb + 1)) REPEAT(3) {
            PHASE_VIEW();
            WSP(bf16, P, WS_P);
            REPEAT(13) {
                WSP(bf16, QA, WS_QA); WSP(bf16, KA, WS_KA); WSP(bf16, VAT, WS_VA);
                const float* qn = inp[I_SWAQN] + l * 64; const float* kn = inp[I_SWAKN] + l * 64;
                const int d0 = (lane & 15) * 4;
                const f32x4 gq4 = *(const f32x4*)(qn + d0), gk4 = *(const f32x4*)(kn + d0);
                const int ax = d0 >> 5, ph = (d0 >> 4) & 1, f0 = d0 & 15;
                float fr4[4];
#pragma unroll
                for (int i = 0; i < 4; ++i) fr4[i] = exp2f(-(float)(f0 + i) * (13.287712379549449f / 16.f));
                LAS bf16* vtw = (LAS bf16*)(lds + wave * 9216);
                for (int grp = wave * G + bid; grp < MT / 32; grp += NGW) {
                    const int row0 = grp * 32; const bool lat = row0 < ML;
                    const int b = lat ? (row0 >> 11) : ((row0 - ML) >> 8); const int kk0 = lat ? (CL + (row0 & (SEQ - 1))) : ((row0 - ML) & (CL - 1));
                    v2u rq[4], rk[4]; bf16 rv[4][2];
#pragma unroll
                    for (int u = 0; u < 4; ++u) { const bf16* pr = P + (size_t)(row0 + u) * NINP; rq[u] = *(const v2u*)(pr + PC_AQ + 4 * lane); rk[u] = *(const v2u*)(pr + PC_AK + 4 * (lane & 31));
                        rv[u][0] = pr[PC_AV + lane]; rv[u][1] = pr[PC_AV + 64 + lane]; }
#pragma unroll 1
                    for (int tb = 0; tb < 8; ++tb) {
                        v2u nq[4], nk[4]; bf16 nv[4][2];
                        const int rn = row0 + ((tb + 1) & 7) * 4;
#pragma unroll
                        for (int u = 0; u < 4; ++u) { const bf16* pr = P + (size_t)(rn + u) * NINP; nq[u] = *(const v2u*)(pr + PC_AQ + 4 * lane); nk[u] = *(const v2u*)(pr + PC_AK + 4 * (lane & 31));
                            nv[u][0] = pr[PC_AV + lane]; nv[u][1] = pr[PC_AV + 64 + lane]; }
#pragma unroll
                        for (int u = 0; u < 4; ++u) {
                            const int ti = tb * 4 + u; const int row = row0 + ti; const int t = row & (SEQ - 1);
                            const float pos = (float)(ax == 0 ? (t >> 6) : (t & 63));
                            float cs[4], sn[4];
#pragma unroll
                            for (int i = 0; i < 4; ++i) { const float ang = pos * fr4[i]; cs[i] = __cosf(ang); sn[i] = __sinf(ang); }
#pragma unroll
                            for (int isk = 0; isk < 2; ++isk) {
                                const v2u raw = isk ? rk[u] : rq[u];
                                float x[4] = {bflo(raw.x), bfhi(raw.x), bflo(raw.y), bfhi(raw.y)};
                                float ss = (x[0] * x[0] + x[1] * x[1]) + (x[2] * x[2] + x[3] * x[3]);
                                ss += dpp_mov<0xB1>(ss); ss += dpp_mov<0x4E>(ss); ss += dpp_mov<0x141>(ss); ss += dpp_mov<0x140>(ss);
                                const float rs = rsqrtf(ss * (1.f / 64.f) + EPS);
                                const f32x4 gg = isk ? gk4 : gq4;
                                float y[4], yp[4];
#pragma unroll
                                for (int i = 0; i < 4; ++i) { y[i] = x[i] * rs * gg[i]; yp[i] = __shfl_xor(y[i], 4); }
                                if (lat) {
#pragma unroll
                                    for (int i = 0; i < 4; ++i) y[i] = (ph == 0) ? (y[i] * cs[i] - yp[i] * sn[i]) : (y[i] * cs[i] + yp[i] * sn[i]); }
                                v2u o; o.x = pk2(y[0], y[1]); o.y = pk2(y[2], y[3]);
                                if (!isk) *(v2u*)(QA + (size_t)row * 256 + 4 * lane) = o;
                                else if (lane < 32) *(v2u*)(KA + ((size_t)(b * 2 + (lane >> 4)) * KT + kk0 + ti) * 64 + d0) = o;
                            }
                            const int pp = ((ti & 12) << 1) | ((ti & 16) >> 2) | (ti & 3);
                            vtw[lane * 36 + pp] = rv[u][0]; vtw[(64 + lane) * 36 + pp] = rv[u][1];
                        }
#pragma unroll
                        for (int u = 0; u < 4; ++u) { rq[u] = nq[u]; rk[u] = nk[u]; rv[u][0] = nv[u][0]; rv[u][1] = nv[u][1]; }
                    }
                    asm volatile("s_waitcnt lgkmcnt(0)" ::: "memory");
#pragma unroll
                    for (int hk = 0; hk < 2; ++hk) { const LAS bf16* src = vtw + (hk * 64 + lane) * 36; bf16* dst = VAT + ((size_t)(b * 2 + hk) * 64 + lane) * KT + kk0;
#pragma unroll
                        for (int q4 = 0; q4 < 4; ++q4) { const v2u a0 = *(const LAS v2u*)(src + 8 * q4), a1 = *(const LAS v2u*)(src + 8 * q4 + 4); v4u o; o.x = a0.x; o.y = a0.y; o.z = a1.x; o.w = a1.y; *(v4u*)(dst + 8 * q4) = o; } }
                    asm volatile("s_waitcnt lgkmcnt(0)" ::: "memory");
                }
            }
            __syncthreads();
            REPEAT(14) {
                WSP(bf16, GW, WS_GW); WSP(bf16, GQD, WS_GQD); WSP(bf16, GKDT, WS_GKDT); WSP(bf16, GQKM, WS_GQKM); WSP(bf16, GUT, WS_GUT); WSP(float, GGE, WS_GGE);
                const float* cw = inp[I_CONV] + (size_t)l * 5 * 1536;
                LAS float* VF = (LAS float*)lds;
                LAS bf16* Qb = (LAS bf16*)(lds + 32768);
                LAS bf16* Kb = (LAS bf16*)(lds + 51200);
                LAS bf16* LH = (LAS bf16*)(lds + 69632);
                LAS bf16* LL = (LAS bf16*)(lds + 69632 + 18432);
                LAS bf16* TH = (LAS bf16*)(lds + 69632 + 36864);
                LAS bf16* TL = (LAS bf16*)(lds + 69632 + 47104);
                LAS float* GC = (LAS float*)(lds + 147456);
                LAS float* BT = GC + 128;
                const int c = lane & 15, g = lane >> 4;
                for (int item = bid; item < NB * 4 * 36; item += G) {
                    const int b = item / 144, hh = (item / 36) & 3, ct = item % 36;
                    const bool latc = ct >= 4; const int p0 = latc ? 64 * (ct - 4) : 64 * ct; const int Ls = latc ? SEQ : CL;
                    const int rowbase = latc ? b * SEQ + p0 : ML + b * CL + p0;
                    __syncthreads();
                    int tidl = tid; asm volatile("" : "+v"(tidl));
                    REPEAT(17) {
                        const int wv = __builtin_amdgcn_readfirstlane(tidl >> 6), ln = tidl & 63;
                        if (wv < 4) {
                            const int which = wv & 1, part = wv >> 1, ch = which * 512 + hh * 128 + 2 * ln;
                            float w0[5], w1[5];
#pragma unroll
                            for (int w = 0; w < 5; ++w) { w0[w] = cw[w * 1536 + ch]; w1[w] = cw[w * 1536 + ch + 1]; }
                            unsigned xin[36];
#pragma unroll
                            for (int j = 0; j < 36; ++j) { const int tl = 32 * part - 2 + j; const int pos = p0 + tl;
                                xin[j] = (pos >= 0 && pos < Ls) ? *(const unsigned*)(P + (size_t)(rowbase + tl) * NINP + PC_GQ + ch) : 0u; }
                            float y0[32], y1[32];
#pragma unroll
                            for (int j = 0; j < 32; ++j) { float a0 = 0.f, a1 = 0.f;
#pragma unroll
                                for (int w = 0; w < 5; ++w) { a0 += bflo(xin[j + w]) * w0[w]; a1 += bfhi(xin[j + w]) * w1[w]; }
                                y0[j] = siluf(a0); y1[j] = siluf(a1); }
                            float p[32];
#pragma unroll
                            for (int j = 0; j < 32; ++j) p[j] = y0[j] * y0[j] + y1[j] * y1[j];
#pragma unroll
                            for (int k = 0; k < 5; ++k) { const bool bit = (ln >> k) & 1;
#pragma unroll
                                for (int i = 0; i < (16 >> k); ++i) { const float keep = bit ? p[2 * i + 1] : p[2 * i], give = bit ? p[2 * i] : p[2 * i + 1]; const float recv = (k == 0) ? dpp_mov<0xB1>(give) : (k == 1) ? dpp_mov<0x4E>(give) : __shfl_xor(give, 1 << k);
                                        p[i] = keep + recv; } }
                            const float tot = p[0] + __shfl_xor(p[0], 32);
                            const float scl = rsqrtf(tot + EPS) * (which == 0 ? 0.08838834764831845f : 1.f);
                            LAS bf16* dstb = (which == 0 ? Qb : Kb) + (32 * part) * 144 + 2 * ln;
#pragma unroll
                            for (int j = 0; j < 32; ++j) { const float sj = __builtin_bit_cast(float, __builtin_amdgcn_readlane(__builtin_bit_cast(int, scl), j));
                                *(LAS unsigned*)(dstb + j * 144) = pk2(y0[j] * sj, y1[j] * sj); }
                        } else {
                            unsigned short ga_raw = 0, gb_raw = 0; float dtb_v = 0.f, alog_v = 0.f;
                            if (wv >= 6) { const int dd = wv - 6, tl = dd ? 63 - ln : ln; const bf16* pr = P + (size_t)(rowbase + tl) * NINP;
                                ga_raw = pr[PC_GA + dd * 4 + hh]; gb_raw = pr[PC_GB + dd * 4 + hh]; dtb_v = inp[I_DTB][l * 8 + dd * 4 + hh]; alog_v = inp[I_ALOG][l * 8 + dd * 4 + hh]; }
                            {
                                const int vq = wv - 4, ch = 1024 + hh * 128 + 2 * ln;
                                float w0[5], w1[5];
#pragma unroll
                                for (int w = 0; w < 5; ++w) { w0[w] = cw[w * 1536 + ch]; w1[w] = cw[w * 1536 + ch + 1]; }
                                unsigned xin[20];
#pragma unroll
                                for (int j = 0; j < 20; ++j) { const int tl = 16 * vq - 2 + j; const int pos = p0 + tl;
                                    xin[j] = (pos >= 0 && pos < Ls) ? *(const unsigned*)(P + (size_t)(rowbase + tl) * NINP + PC_GQ + ch) : 0u; }
#pragma unroll
                                for (int j = 0; j < 16; ++j) { float a0 = 0.f, a1 = 0.f;
#pragma unroll
                                    for (int w = 0; w < 5; ++w) { a0 += bflo(xin[j + w]) * w0[w]; a1 += bfhi(xin[j + w]) * w1[w]; }
                                    *(LAS f32x2_t*)(VF + (16 * vq + j) * 128 + 2 * ln) = (f32x2_t){siluf(a0), siluf(a1)}; }
                            }
                            if (wv >= 6) {
                                const int dd = wv - 6;
                                const float a = bf2f(ga_raw) + dtb_v;
                                const float ea = __expf(a); const float sp = (a > 20.f) ? a : ((a < -9.f) ? ea * (1.f - 0.5f * ea) : __logf(1.f + ea));
                                float gv = -__expf(alog_v) * sp;
                                BT[dd * 64 + ln] = __builtin_amdgcn_rcpf(1.f + __expf(-bf2f(gb_raw)));
#pragma unroll
                                for (int off = 1; off < 64; off <<= 1) { const float tv = __shfl_up(gv, off); if (ln >= off) gv += tv; }
                                GC[dd * 64 + ln] = gv;
                            }
                        }
                    }
                    __syncthreads();
                    const int cs0 = ct, cs1 = (ct < 4) ? 3 - ct : 39 - ct;
                    const size_t it0 = ((size_t)(0 * NB + b) * 4 + hh) * 36 + cs0, it1 = ((size_t)(1 * NB + b) * 4 + hh) * 36 + cs1;
                    REPEAT(18) {
                        const int wv = __builtin_amdgcn_readfirstlane(tidl >> 6), c = tidl & 15, g = (tidl >> 4) & 3; const int mb = wv >> 1, nb0 = 2 * (wv & 1);
                        bf16x8_t ka[4];
#pragma unroll
                        for (int ks = 0; ks < 4; ++ks) ka[ks] = *(const LAS bf16x8_t*)(Kb + (16 * mb + c) * 144 + 32 * ks + 8 * g);
#pragma unroll
                        for (int nbi = 0; nbi < 2; ++nbi) { const int nb = nb0 + nbi;
                            f32x4 kk = (f32x4){0.f, 0.f, 0.f, 0.f}, qk = (f32x4){0.f, 0.f, 0.f, 0.f};
#pragma unroll
                            for (int ks = 0; ks < 4; ++ks) { const bf16x8_t kb = *(const LAS bf16x8_t*)(Kb + (16 * nb + c) * 144 + 32 * ks + 8 * g), qb = *(const LAS bf16x8_t*)(Qb + (16 * nb + c) * 144 + 32 * ks + 8 * g);
                                kk = __builtin_amdgcn_mfma_f32_16x16x32_bf16(ka[ks], kb, kk, 0, 0, 0); qk = __builtin_amdgcn_mfma_f32_16x16x32_bf16(ka[ks], qb, qk, 0, 0, 0); }
                            asm volatile("" ::: "memory");
#pragma unroll
                            for (int dd = 0; dd < 2; ++dd) {
                                const int s = dd ? 63 - 16 * nb - c : 16 * nb + c, ip0 = dd ? 60 - 16 * mb - 4 * g : 16 * mb + 4 * g;
                                const float gs = GC[dd * 64 + s], bs = BT[dd * 64 + s]; const f32x4 gi = *(const LAS f32x4*)(GC + dd * 64 + ip0);
                                float lv[4], qv[4];
#pragma unroll
                                for (int j = 0; j < 4; ++j) { const int ip = ip0 + j; const float dec = (ip <= s) ? __expf(gs - gi[j]) : 0.f; const int i = dd ? 3 - j : j;
                                    lv[j] = (ip < s) ? bs * kk[i] * dec : 0.f; qv[j] = qk[i] * dec; }
                                v2u h, lo; h.x = pk2(lv[0], lv[1]); h.y = pk2(lv[2], lv[3]);
                                lo.x = pk2(lv[0] - __builtin_bit_cast(float, h.x << 16), lv[1] - __builtin_bit_cast(float, h.x & 0xffff0000u));
                                lo.y = pk2(lv[2] - __builtin_bit_cast(float, h.y << 16), lv[3] - __builtin_bit_cast(float, h.y & 0xffff0000u));
                                *(LAS v2u*)(LH + (dd * 64 + s) * 72 + ip0) = h; *(LAS v2u*)(LL + (dd * 64 + s) * 72 + ip0) = lo;
                                v2u qo; qo.x = pk2(qv[0], qv[1]); qo.y = pk2(qv[2], qv[3]);
                                *(v2u*)(GQKM + (dd ? it1 : it0) * 4096 + (((s >> 4) * 2 + (ip0 >> 5)) * 64 + ((ip0 & 31) >> 3) * 16 + (s & 15)) * 8 + (ip0 & 7)) = qo; }
                        }
                    }
                    __syncthreads();
                    REPEAT(19) {
                        const int wv = __builtin_amdgcn_readfirstlane(tidl >> 6), ln = tidl & 63; const int dd = wv >> 2, blk = wv & 3;
                        if (ln < 16) { float t[16];
#pragma unroll
                            for (int r = 0; r < 16; ++r) { float acc = (r == ln) ? 1.f : 0.f;
                                const int off = (dd * 64 + 16 * blk + r) * 72 + 16 * blk;
                                if (r > 0) { const v4u h0 = *(const LAS v4u*)(LH + off), l0 = *(const LAS v4u*)(LL + off);
#pragma unroll
                                    for (int i = 0; i < (r < 8 ? r : 8); ++i) { const unsigned hw = h0[i >> 1], lw = l0[i >> 1]; acc -= ((i & 1) ? bfhi(hw) + bfhi(lw) : bflo(hw) + bflo(lw)) * t[i]; } }
                                if (r > 8) { const v4u h1 = *(const LAS v4u*)(LH + off + 8), l1 = *(const LAS v4u*)(LL + off + 8);
#pragma unroll
                                    for (int i = 8; i < r; ++i) { const unsigned hw = h1[(i - 8) >> 1], lw = l1[(i - 8) >> 1]; acc -= ((i & 1) ? bfhi(hw) + bfhi(lw) : bflo(hw) + bflo(lw)) * t[i]; } }
                                t[r] = acc; }
#pragma unroll
                            for (int r = 0; r < 16; ++r) { const unsigned hi16 = f2bf(t[r]); const int off = ((dd * 4 + blk) * 16 + r) * 40 + ln;
                                TH[off] = (bf16)hi16; TL[off] = (bf16)f2bf(t[r] - __builtin_bit_cast(float, hi16 << 16)); } }
                    }
                    __syncthreads();
                    REPEAT(20) {
                        const int wv = __builtin_amdgcn_readfirstlane(tidl >> 6), ln = tidl & 63, c = ln & 15, g = ln >> 4; const int dd = wv >> 2;
                        const size_t itd = dd ? it1 : it0;
                        const int ct0 = 4 * (wv & 3);
                        auto solve = [&](auto isu_c) {
                        constexpr bool isu = decltype(isu_c)::value;
                        v2u xb[4][4];
#pragma unroll
                        for (int q = 0; q < 4; ++q)
#pragma unroll
                            for (int k = 0; k < 4; ++k) xb[q][k] = (v2u){0u, 0u};
#pragma unroll
                        for (int blk = 0; blk < 4; ++blk) {
                            const int arow = (dd * 64 + 16 * blk + c) * 72 + 4 * g;
                            v4u ah[2], al[2];
#pragma unroll
                            for (int ch = 0; ch < 2; ++ch) if ((ch == 0 && blk >= 1) || (ch == 1 && blk == 3)) {
                                const v2u a0 = *(const LAS v2u*)(LH + arow + 32 * ch), a1 = *(const LAS v2u*)(LH + arow + 32 * ch + 16), b0 = *(const LAS v2u*)(LL + arow + 32 * ch), b1 = *(const LAS v2u*)(LL + arow + 32 * ch + 16);
                                ah[ch] = (v4u){a0.x, a0.y, a1.x, a1.y}; al[ch] = (v4u){b0.x, b0.y, b1.x, b1.y}; }
                            const int toff = ((dd * 4 + blk) * 16 + c) * 40 + 4 * g;
                            const v2u t0 = *(const LAS v2u*)(TH + toff), t1 = *(const LAS v2u*)(TL + toff);
                            const bf16x8_t th = __builtin_bit_cast(bf16x8_t, ((v4u){t0.x, t0.y, 0u, 0u})), tlw = __builtin_bit_cast(bf16x8_t, ((v4u){t1.x, t1.y, 0u, 0u}));
                            const f32x4 bt4 = *(const LAS f32x4*)(BT + dd * 64 + 16 * blk + 4 * g), gc4 = *(const LAS f32x4*)(GC + dd * 64 + 16 * blk + 4 * g);
                            float sc[4];
#pragma unroll
                            for (int i = 0; i < 4; ++i) sc[i] = isu ? bt4[i] : bt4[i] * __expf(gc4[i]);
                            f32x4 rhs[4];
#pragma unroll
                            for (int q = 0; q < 4; ++q) { const int cl = (16 * (ct0 + q) + c) & 127;
#pragma unroll
                                for (int i = 0; i < 4; ++i) { const int s = 16 * blk + 4 * g + i, tl = dd ? 63 - s : s;
                                    float rv; if constexpr (isu) rv = VF[tl * 128 + cl]; else rv = bf2f(Kb[tl * 144 + cl]);
                                    rhs[q][i] = sc[i] * rv; } }
#pragma unroll
                            for (int q = 0; q < 4; ++q) {
                                const int ctile = ct0 + q;
                                f32x4 prod = (f32x4){0.f, 0.f, 0.f, 0.f};
#pragma unroll
                                for (int ch = 0; ch < 2; ++ch) if ((ch == 0 && blk >= 1) || (ch == 1 && blk == 3)) {
                                    const bf16x8_t xbf = __builtin_bit_cast(bf16x8_t, ((v4u){xb[q][2 * ch].x, xb[q][2 * ch].y, xb[q][2 * ch + 1].x, xb[q][2 * ch + 1].y}));
                                    prod = __builtin_amdgcn_mfma_f32_16x16x32_bf16(__builtin_bit_cast(bf16x8_t, ah[ch]), xbf, prod, 0, 0, 0);
                                    prod = __builtin_amdgcn_mfma_f32_16x16x32_bf16(__builtin_bit_cast(bf16x8_t, al[ch]), xbf, prod, 0, 0, 0); }
                                const f32x4 y = rhs[q] - prod;
                                const bf16x8_t yb = __builtin_bit_cast(bf16x8_t, ((v4u){pk2(y.x, y.y), pk2(y.z, y.w), 0u, 0u}));
                                f32x4 x = (f32x4){0.f, 0.f, 0.f, 0.f};
                                x = __builtin_amdgcn_mfma_f32_16x16x32_bf16(th, yb, x, 0, 0, 0); x = __builtin_amdgcn_mfma_f32_16x16x32_bf16(tlw, yb, x, 0, 0, 0);
                                xb[q][blk].x = pk2(x.x, x.y); xb[q][blk].y = pk2(x.z, x.w);
                                if constexpr (isu) *(v2u*)(GUT + itd * 8192 + ((ctile * 4 + blk) * 64 + ln) * 4) = xb[q][blk];
                                else {
                                    f32x4 xt = (f32x4){0.f, 0.f, 0.f, 0.f};
                                    xt = __builtin_amdgcn_mfma_f32_16x16x32_bf16(yb, th, xt, 0, 0, 0); xt = __builtin_amdgcn_mfma_f32_16x16x32_bf16(yb, tlw, xt, 0, 0, 0);
                                    const int kd0 = 16 * (ctile - 8) + 4 * g; v2u o; o.x = pk2(xt.x, xt.y); o.y = pk2(xt.z, xt.w);
                                    *(v2u*)(GW + itd * 8192 + ((blk * 4 + (kd0 >> 5)) * 64 + ((kd0 & 31) >> 3) * 16 + c) * 8 + (kd0 & 7)) = o; }
                            }
                        }
                        };
                        if ((wv & 2) == 0) solve(std::true_type{}); else solve(std::false_type{});
                    }
                    REPEAT(21) {
                        WSP(bf16, GQN, WS_GQD); WSP(bf16, GKT, WS_GKDT); float* GCG = (float*)(wsb + WS_GQD + 40 * MiB);
                        const size_t iq = (size_t)(b * 4 + hh) * 36 + ct;
                        for (int f = tidl; f < 1024; f += NTHR) { const int mbq = f >> 8, ksq = (f >> 6) & 3, r = f & 15, gg = (f >> 4) & 3;
                            *(v4u*)(GQN + iq * 8192 + (size_t)f * 8) = *(const LAS v4u*)(Qb + (16 * mbq + r) * 144 + 32 * ksq + 8 * gg); }
                        for (int f = tidl; f < 1024; f += NTHR) { const int kbq = f >> 7, ksq = (f >> 6) & 1, r = f & 15, gg = (f >> 4) & 3; const int kd = 16 * kbq + r, tb = 32 * ksq + 8 * gg;
                            v4u o; o.x = (unsigned)Kb[(tb + 0) * 144 + kd] | ((unsigned)Kb[(tb + 1) * 144 + kd] << 16); o.y = (unsigned)Kb[(tb + 2) * 144 + kd] | ((unsigned)Kb[(tb + 3) * 144 + kd] << 16);
                            o.z = (unsigned)Kb[(tb + 4) * 144 + kd] | ((unsigned)Kb[(tb + 5) * 144 + kd] << 16); o.w = (unsigned)Kb[(tb + 6) * 144 + kd] | ((unsigned)Kb[(tb + 7) * 144 + kd] << 16);
                            *(v4u*)(GKT + iq * 8192 + (size_t)f * 8) = o; }
                        if (tidl < 128) GCG[((tidl >> 6) ? it1 : it0) * 64 + (tidl & 63)] = GC[tidl];
                    }
                }
            }
            __syncthreads();
            REPEAT(15) {
                WSP(bf16, QM, WS_QM); WSP(bf16, KM, WS_KM); WSP(bf16, VMT, WS_VM);
                const int per = (MT + G - 1) / G, r0 = bid * per, r1 = (r0 + per < MT) ? r0 + per : MT, ngrp = (r1 - r0 + 15) >> 4;
                LAS float* ssq = (LAS float*)lds;
                {
                    int ln_ = tid; asm volatile("" : "+v"(ln_)); const int c = ln_ & 15, g = (ln_ >> 4) & 3;
                    const float* gq = inp[I_MQN] + l * 96; WSP(bf16, WUQF, WS_WUQF);
                    bf16x8_t wf[3][8];
#pragma unroll
                    for (int nb = 0; nb < 3; ++nb)
#pragma unroll
                        for (int ks = 0; ks < 8; ++ks) wf[nb][ks] = *(const bf16x8_t*)(WUQF + ((size_t)l * 384 + 48 * wave + 16 * nb + c) * 256 + 32 * ks + 8 * g);
                    const int hh = wave >> 1, dbase = 48 * (wave & 1);
                    f32x4 gqv[3];
#pragma unroll
                    for (int nb = 0; nb < 3; ++nb) gqv[nb] = *(const f32x4*)(gq + dbase + 16 * nb + 4 * g);
                    v4u nraw[8];
                    { const int rw = (r0 + c < r1) ? r0 + c : r1 - 1; const bf16* pr = P + (size_t)rw * NINP + PC_CQ + 8 * g;
#pragma unroll
                      for (int ks = 0; ks < 8; ++ks) nraw[ks] = *(const v4u*)(pr + 32 * ks); }
                    for (int grp = 0; grp < ngrp; ++grp) {
                        const int rowv = r0 + 16 * grp + c; const bool valid = rowv < r1; const int row = valid ? rowv : r1 - 1;
                        v4u craw[8];
#pragma unroll
                        for (int ks = 0; ks < 8; ++ks) craw[ks] = nraw[ks];
                        if (grp + 1 < ngrp) { const int rn = (rowv + 16 < r1) ? rowv + 16 : r1 - 1; const bf16* prn = P + (size_t)rn * NINP + PC_CQ + 8 * g;
#pragma unroll
                            for (int ks = 0; ks < 8; ++ks) nraw[ks] = *(const v4u*)(prn + 32 * ks); }
                        bf16x8_t xf[8]; float ss = 0.f;
#pragma unroll
                        for (int ks = 0; ks < 8; ++ks) { const v4u raw = craw[ks]; xf[ks] = __builtin_bit_cast(bf16x8_t, raw);
                            ss += bflo(raw.x) * bflo(raw.x) + bfhi(raw.x) * bfhi(raw.x) + bflo(raw.y) * bflo(raw.y) + bfhi(raw.y) * bfhi(raw.y)
                                + bflo(raw.z) * bflo(raw.z) + bfhi(raw.z) * bfhi(raw.z) + bflo(raw.w) * bflo(raw.w) + bfhi(raw.w) * bfhi(raw.w); }
                        ss += __shfl_xor(ss, 16); ss += __shfl_xor(ss, 32);
                        const float rstd = rsqrtf(ss * (1.f / 256.f) + EPS);
                        f32x4 acc[3]; float hs = 0.f;
#pragma unroll
                        for (int nb = 0; nb < 3; ++nb) { acc[nb] = (f32x4){0.f, 0.f, 0.f, 0.f};
#pragma unroll
                            for (int ks = 0; ks < 8; ++ks) acc[nb] = __builtin_amdgcn_mfma_f32_16x16x32_bf16(wf[nb][ks], xf[ks], acc[nb], 0, 0, 0);
                            acc[nb] = acc[nb] * rstd; hs += (acc[nb].x * acc[nb].x + acc[nb].y * acc[nb].y) + (acc[nb].z * acc[nb].z + acc[nb].w * acc[nb].w); }
                        hs += __shfl_xor(hs, 16); hs += __shfl_xor(hs, 32);
                        LAS float* sq = ssq + (grp & 1) * 128;
                        if (g == 0) sq[wave * 16 + c] = hs;
                        __syncthreads();
                        const float rs = rsqrtf((sq[wave * 16 + c] + sq[(wave ^ 1) * 16 + c]) * (1.f / 96.f) + EPS);
                        const bool lat = row < ML; const int t = row & (SEQ - 1);
#pragma unroll
                        for (int nb = 0; nb < 3; ++nb) { const int d0 = dbase + 16 * nb + 4 * g;
                            f32x4 y = acc[nb] * rs * gqv[nb];
                            if (d0 >= 64) {
                                f32x4 yp; yp.x = __shfl_xor(y.x, 32); yp.y = __shfl_xor(y.y, 32); yp.z = __shfl_xor(y.z, 32); yp.w = __shfl_xor(y.w, 32);
                                { const int r = d0 - 64; const int ax = r >> 4, ph = (r >> 3) & 1; const float pos = (float)(ax == 0 ? (t >> 6) : (t & 63));
#pragma unroll
                                    for (int i = 0; i < 4; ++i) { const float ang = pos * exp2f(-(float)((r & 7) + i) * (13.287712379549449f / 8.f)); const float cs = lat ? __cosf(ang) : 1.f, sn = lat ? __sinf(ang) : 0.f;
                                        y[i] = (ph == 0) ? (y[i] * cs - yp[i] * sn) : (y[i] * cs + yp[i] * sn); } } }
                            if (valid) { v2u o; o.x = pk2(y.x, y.y); o.y = pk2(y.z, y.w); *(v2u*)(QM + (size_t)row * 384 + hh * 96 + d0) = o; } }
                    }
                }
                __syncthreads();
                {
                    int ln_ = tid; asm volatile("" : "+v"(ln_)); const int c = ln_ & 15, g = (ln_ >> 4) & 3;
                    const float* gk = inp[I_MKN] + l * 96; WSP(bf16, WUKVF, WS_WUKVF);
                    bf16x8_t wf[4][4];
#pragma unroll
                    for (int nb = 0; nb < 4; ++nb)
#pragma unroll
                        for (int ks = 0; ks < 4; ++ks) wf[nb][ks] = *(const bf16x8_t*)(WUKVF + ((size_t)l * 512 + 64 * wave + 16 * nb + c) * 128 + 32 * ks + 8 * g);
                    const int hh = wave >> 1;
                    f32x4 gkv[4]; float gkr[8];
#pragma unroll
                    for (int nb = 0; nb < 4; ++nb) gkv[nb] = *(const f32x4*)(gk + 16 * nb + 4 * g);
#pragma unroll
                    for (int j = 0; j < 8; ++j) gkr[j] = gk[64 + 8 * g + j];
                    v4u nraw[4], nrr;
                    { const int rw = (r0 + c < r1) ? r0 + c : r1 - 1; const bf16* pr = P + (size_t)rw * NINP + PC_CKV + 8 * g;
#pragma unroll
                      for (int ks = 0; ks < 4; ++ks) nraw[ks] = *(const v4u*)(pr + 32 * ks);
                      nrr = *(const v4u*)(P + (size_t)rw * NINP + PC_CKR + 8 * g); }
                    for (int grp = 0; grp < ngrp; ++grp) {
                        const int rowv = r0 + 16 * grp + c; const bool valid = rowv < r1; const int row = valid ? rowv : r1 - 1;
                        v4u craw[4]; const v4u rr = nrr;
#pragma unroll
                        for (int ks = 0; ks < 4; ++ks) craw[ks] = nraw[ks];
                        if (grp + 1 < ngrp) { const int rn = (rowv + 16 < r1) ? rowv + 16 : r1 - 1; const bf16* prn = P + (size_t)rn * NINP + PC_CKV + 8 * g;
#pragma unroll
                            for (int ks = 0; ks < 4; ++ks) nraw[ks] = *(const v4u*)(prn + 32 * ks);
                            nrr = *(const v4u*)(P + (size_t)rn * NINP + PC_CKR + 8 * g); }
                        bf16x8_t xf[4]; float ss = 0.f;
#pragma unroll
                        for (int ks = 0; ks < 4; ++ks) { const v4u raw = craw[ks]; xf[ks] = __builtin_bit_cast(bf16x8_t, raw);
                            ss += bflo(raw.x) * bflo(raw.x) + bfhi(raw.x) * bfhi(raw.x) + bflo(raw.y) * bflo(raw.y) + bfhi(raw.y) * bfhi(raw.y)
                                + bflo(raw.z) * bflo(raw.z) + bfhi(raw.z) * bfhi(raw.z) + bflo(raw.w) * bflo(raw.w) + bfhi(raw.w) * bfhi(raw.w); }
                        ss += __shfl_xor(ss, 16); ss += __shfl_xor(ss, 32);
                        const float rstd = rsqrtf(ss * (1.f / 128.f) + EPS);
                        f32x4 acc[4]; float hs = 0.f;
#pragma unroll
                        for (int nb = 0; nb < 4; ++nb) { acc[nb] = (f32x4){0.f, 0.f, 0.f, 0.f};
#pragma unroll
                            for (int ks = 0; ks < 4; ++ks) acc[nb] = __builtin_amdgcn_mfma_f32_16x16x32_bf16(wf[nb][ks], xf[ks], acc[nb], 0, 0, 0);
                            acc[nb] = acc[nb] * rstd; hs += (acc[nb].x * acc[nb].x + acc[nb].y * acc[nb].y) + (acc[nb].z * acc[nb].z + acc[nb].w * acc[nb].w); }
                        const bool lat = row < ML; const int t = row & (SEQ - 1);
                        const int b = lat ? (row >> 11) : ((row - ML) >> 8); const int kk = lat ? (CL + t) : ((row - ML) & (CL - 1));
                        if ((wave & 1) == 0) {
                            float kr[8] = {bflo(rr.x), bfhi(rr.x), bflo(rr.y), bfhi(rr.y), bflo(rr.z), bfhi(rr.z), bflo(rr.w), bfhi(rr.w)};
#pragma unroll
                            for (int j = 0; j < 8; ++j) hs += kr[j] * kr[j];
                            hs += __shfl_xor(hs, 16); hs += __shfl_xor(hs, 32);
                            const float rs = rsqrtf(hs * (1.f / 96.f) + EPS);
                            bf16* kd = KM + ((size_t)(b * 4 + hh) * KT + kk) * 96;
#pragma unroll
                            for (int nb = 0; nb < 4; ++nb) { const int d0 = 16 * nb + 4 * g; const f32x4 y = acc[nb] * rs * gkv[nb];
                                if (valid) { v2u o; o.x = pk2(y.x, y.y); o.y = pk2(y.z, y.w); *(v2u*)(kd + d0) = o; } }
                            const int ax = g >> 1, ph = g & 1; const float pos = (float)(ax == 0 ? (t >> 6) : (t & 63));
                            float yr[8];
#pragma unroll
                            for (int j = 0; j < 8; ++j) { const float y = kr[j] * rs * gkr[j]; const float yp = __shfl_xor(y, 16);
                                const float ang = pos * exp2f(-(float)j * (13.287712379549449f / 8.f)); const float cs = lat ? __cosf(ang) : 1.f, sn = lat ? __sinf(ang) : 0.f;
                                yr[j] = (ph == 0) ? (y * cs - yp * sn) : (y * cs + yp * sn); }
                            if (valid) { v4u o; o.x = pk2(yr[0], yr[1]); o.y = pk2(yr[2], yr[3]); o.z = pk2(yr[4], yr[5]); o.w = pk2(yr[6], yr[7]); *(v4u*)(kd + 64 + 8 * g) = o; }
                        } else {
                            bf16* vd = VMT + (size_t)(b * 4 + hh) * 64 * KT + ((kk & ~31) | ((kk & 12) << 1) | ((kk & 16) >> 2) | (kk & 3));
                            if (valid) {
#pragma unroll
                                for (int nb = 0; nb < 4; ++nb)
#pragma unroll
                                    for (int i = 0; i < 4; ++i) vd[(size_t)(16 * nb + 4 * g + i) * KT] = (bf16)f2bf(acc[nb][i]); }
                        }
                    }
                }
            }
        }
        SEAM(pb + 1);

        if (IN(pb + 2)) {
            PHASE_VIEW();
            REPEAT(4) {
                WSP(bf16, GW, WS_GW); WSP(bf16, GQN, WS_GQD); WSP(bf16, GKT, WS_GKDT); WSP(bf16, GQKM, WS_GQKM); WSP(bf16, GUT, WS_GUT); WSP(bf16, OD, WS_OD); const float* GCG = (const float*)(wsb + WS_GQD + 40 * MiB);
                LAS bf16* ST = (LAS bf16*)lds;
                LAS bf16* VT = (LAS bf16*)(lds + 36864);
                LAS bf16* VT2 = (LAS bf16*)(lds + 36864 + 20480);
                const int c = lane & 15, g = lane >> 4, mb = wave >> 1, nb0 = 4 * (wave & 1);
                const bool xcdaware = (G & 7) == 0 && G >= 128;
                const int nscan = xcdaware ? 128 : (G < 128 ? G : 128), sci = xcdaware ? ((bid >> 3) < 16 ? (bid >> 3) * 8 + (bid & 7) : 128) : (bid < 128 ? bid : 128);
                for (int ci = sci; ci < 128; ci += nscan) {
                    const int idx = ci >> 3, xq = ci & 7; const int dd = idx & 1, bh = (idx >> 1) * 8 + xq, b = bh >> 2, hh = bh & 3; const int chain = (dd * 16 + b) * 4 + hh;
                    __syncthreads();
                    { unsigned z_ = 0u; asm volatile("" : "+v"(z_));
                      for (int i = tid; i < 36864 / 16; i += NTHR) *(LAS v4u*)(lds + 16 * i) = (v4u){z_, z_, z_, z_}; }
                    f32x4 Sm[8];
#pragma unroll
                    for (int nb = 0; nb < 8; ++nb) Sm[nb] = (f32x4){0.f, 0.f, 0.f, 0.f};
                    const size_t itb = (size_t)chain * 36;
                    bf16x8_t nw[4], nq[4], nm[2], nk[2]; v2u nu[4]; f32x4 ngc; float nge;
                    const unsigned o_w = (unsigned)(mb * 4) * 1024u + (unsigned)lane * 16u;
                    const unsigned o_qn = dd ? (unsigned)((3 - mb) * 4) * 1024u + (unsigned)(g * 16 + (15 - c)) * 16u : o_w;
                    const unsigned o_m = (unsigned)(mb * 2) * 1024u + (unsigned)lane * 16u, o_k = (unsigned)(wave * 2) * 1024u + (unsigned)lane * 16u;
                    const unsigned o_u0 = (unsigned)((nb0 * 4 + mb) * 64 + lane) * 8u;
#define GDN_CT(cs_) (dd ? ((cs_) < 4 ? 3 - (cs_) : 39 - (cs_)) : (cs_))
#define GDN_LOAD_A(cs_) do { const size_t it_ = itb + (cs_); const size_t iq_ = (size_t)(b * 4 + hh) * 36 + GDN_CT(cs_); const char* bw_ = (const char*)GW + it_ * (64 * 128 * 2); const char* bq_ = (const char*)GQN + iq_ * (64 * 128 * 2); \
                        _Pragma("unroll") for (int ks = 0; ks < 4; ++ks) { nw[ks] = *(const bf16x8_t*)(bw_ + o_w + ks * 1024); nq[ks] = *(const bf16x8_t*)(bq_ + o_qn + ks * 1024); } } while (0)
#define GDN_LOAD_B(cs_) do { const size_t it_ = itb + (cs_); const size_t iq_ = (size_t)(b * 4 + hh) * 36 + GDN_CT(cs_); const char* bm_ = (const char*)GQKM + it_ * (64 * 64 * 2); const char* bk_ = (const char*)GKT + iq_ * (128 * 64 * 2); const char* bu_ = (const char*)GUT + it_ * (128 * 64 * 2); \
                        _Pragma("unroll") for (int nbi = 0; nbi < 4; ++nbi) nu[nbi] = *(const v2u*)(bu_ + o_u0 + nbi * 2048); ngc = *(const f32x4*)(GCG + it_ * 64 + 16 * mb + 4 * g); nge = GCG[it_ * 64 + 63]; (void)bm_; (void)bk_; } while (0)
#define GDN_LOAD_C(cs_) do { const size_t it_ = itb + (cs_); const size_t iq_ = (size_t)(b * 4 + hh) * 36 + GDN_CT(cs_); const char* bm_ = (const char*)GQKM + it_ * (64 * 64 * 2); const char* bk_ = (const char*)GKT + iq_ * (128 * 64 * 2); \
                        _Pragma("unroll") for (int ks = 0; ks < 2; ++ks) { nm[ks] = *(const bf16x8_t*)(bm_ + o_m + ks * 1024); nk[ks] = *(const bf16x8_t*)(bk_ + o_k + ks * 1024); } } while (0)
                    GDN_LOAD_A(0); GDN_LOAD_B(0); GDN_LOAD_C(0);
                    __syncthreads();
                    for (int cs = 0; cs < 36; ++cs) {
                        bf16x8_t cw_[4], cq_[4], cm_[2], ck_[2]; v2u cu_[4];
#pragma unroll
                        for (int ks = 0; ks < 4; ++ks) { cw_[ks] = nw[ks]; cq_[ks] = nq[ks]; }
#pragma unroll
                        for (int ks = 0; ks < 2; ++ks) { cm_[ks] = nm[ks]; ck_[ks] = nk[ks]; }
#pragma unroll
                        for (int nbi = 0; nbi < 4; ++nbi) cu_[nbi] = nu[nbi];
                        const float gend = nge; const f32x4 gcv = ngc;
                        const float ge = __expf(gend);
                        f32x4 egc, egk;
#pragma unroll
                        for (int i = 0; i < 4; ++i) { egc[i] = __expf(gcv[i]); egk[i] = __expf(gend - gcv[i]); }
                        if (cs + 1 < 36) { GDN_LOAD_A(cs + 1); GDN_LOAD_B(cs + 1); }
                        f32x4 aqs[4];
                        {
                            bf16x8_t sf[4];
#pragma unroll
                            for (int ks = 0; ks < 4; ++ks) sf[ks] = *(const LAS bf16x8_t*)(ST + (16 * nb0 + c) * 144 + 32 * ks + 8 * g);
#pragma unroll
                            for (int nbi = 0; nbi < 4; ++nbi) {
                                f32x4 wa = (f32x4){0.f, 0.f, 0.f, 0.f}, qa = (f32x4){0.f, 0.f, 0.f, 0.f};
#pragma unroll
                                for (int ks = 0; ks < 4; ++ks) { wa = __builtin_amdgcn_mfma_f32_16x16x32_bf16(cw_[ks], sf[ks], wa, 0, 0, 0); qa = __builtin_amdgcn_mfma_f32_16x16x32_bf16(cq_[ks], sf[ks], qa, 0, 0, 0); }
                                asm volatile("" ::: "memory");
                                if (nbi < 3) {
#pragma unroll
                                    for (int ks = 0; ks < 4; ++ks) sf[ks] = *(const LAS bf16x8_t*)(ST + (16 * (nb0 + nbi + 1) + c) * 144 + 32 * ks + 8 * g); }
                                asm volatile("" ::: "memory");
                                const f32x4 aws = wa; aqs[nbi] = qa * egc;
                                const f32x4 uu = (f32x4){bflo(cu_[nbi].x), bfhi(cu_[nbi].x), bflo(cu_[nbi].y), bfhi(cu_[nbi].y)}; const f32x4 vn = uu - aws;
                                v2u o; o.x = pk2(vn.x, vn.y); o.y = pk2(vn.z, vn.w); *(LAS v2u*)(VT + (16 * (nb0 + nbi) + c) * 80 + 16 * mb + 4 * g) = o;
                                const f32x4 vs = vn * egk;
                                v2u o2; if (dd) { o2.x = pk2(vs.w, vs.z); o2.y = pk2(vs.y, vs.x); } else { o2.x = pk2(vs.x, vs.y); o2.y = pk2(vs.z, vs.w); }
                                *(LAS v2u*)(VT2 + (16 * (nb0 + nbi) + c) * 80 + (dd ? 60 - 16 * mb - 4 * g : 16 * mb + 4 * g)) = o2;
                            }
                        }
                        __syncthreads();
                        if (cs + 1 < 36) GDN_LOAD_C(cs + 1);
                        const int ct = dd ? (cs < 4 ? 3 - cs : 39 - cs) : cs; const int rowbase = (ct >= 4) ? b * SEQ + 64 * (ct - 4) : ML + b * CL + 64 * ct;
#pragma unroll
                        for (int hb = 0; hb < 4; ++hb) {
                            bf16x8_t vf2[2][2];
#pragma unroll
                            for (int n2 = 0; n2 < 2; ++n2)
#pragma unroll
                                for (int ks = 0; ks < 2; ++ks) vf2[n2][ks] = *(const LAS bf16x8_t*)(VT2 + (16 * (2 * hb + n2) + c) * 80 + 32 * ks + 8 * g);
                            __builtin_amdgcn_sched_barrier(0);
#pragma unroll
                            for (int n2 = 0; n2 < 2; ++n2) { const int nb = 2 * hb + n2; Sm[nb] = Sm[nb] * ge;
#pragma unroll
                                for (int ks = 0; ks < 2; ++ks) Sm[nb] = __builtin_amdgcn_mfma_f32_16x16x32_bf16(ck_[ks], vf2[n2][ks], Sm[nb], 0, 0, 0); }
                        }
#pragma unroll
                        for (int hb = 0; hb < 2; ++hb) {
                            bf16x8_t vf[2][2];
#pragma unroll
                            for (int n2 = 0; n2 < 2; ++n2)
#pragma unroll
                                for (int ks = 0; ks < 2; ++ks) vf[n2][ks] = *(const LAS bf16x8_t*)(VT + (16 * (nb0 + 2 * hb + n2) + c) * 80 + 32 * ks + 8 * g);
                            __builtin_amdgcn_sched_barrier(0);
#pragma unroll
                            for (int n2 = 0; n2 < 2; ++n2)
#pragma unroll
                                for (int ks = 0; ks < 2; ++ks) aqs[2 * hb + n2] = __builtin_amdgcn_mfma_f32_16x16x32_bf16(cm_[ks], vf[n2][ks], aqs[2 * hb + n2], 0, 0, 0);
                        }
#pragma unroll
                        for (int nbi = 0; nbi < 4; ++nbi)
#pragma unroll
                            for (int i = 0; i < 4; ++i) { const int s = 16 * mb + 4 * g + i; const int tl = dd ? 63 - s : s;
                                OD[((size_t)dd * MT + rowbase + tl) * 512 + hh * 128 + 16 * (nb0 + nbi) + c] = (bf16)f2bf(aqs[nbi][i]); }
#pragma unroll
                        for (int nb = 0; nb < 8; ++nb) { v2u o; o.x = pk2(Sm[nb].x, Sm[nb].y); o.y = pk2(Sm[nb].z, Sm[nb].w); *(LAS v2u*)(ST + (16 * nb + c) * 144 + 16 * wave + 4 * g) = o; }
                        __syncthreads();
                    }
#undef GDN_LOAD_A
#undef GDN_LOAD_B
#undef GDN_LOAD_C
#undef GDN_CT
                }
            }
            __syncthreads();
            REPEAT(5) {
                WSP(bf16, QA, WS_QA); WSP(bf16, KA, WS_KA); WSP(bf16, VAT, WS_VA); WSP(bf16, QM, WS_QM); WSP(bf16, KM, WS_KM); WSP(bf16, VMT, WS_VM); WSP(bf16, MIX, WS_MIX);
                constexpr float L2E = 1.4426950408889634f;
                const int NU_ML = NB * 4 * 8, NU_SL = NB * 4 * 8, NU_C = (l == 0) ? NB * 4 : 0;
                const int NX = (G % 8 == 0) ? 8 : 1, xx = bid % NX, BPX = G / NX, lb = bid / NX;
                const int NUx_ML = NU_ML / NX, NUx_SL = NU_SL / NX, NUx_C = NU_C / NX;
                unsigned* aq = (unsigned*)(wsb + WS_CTL) + CW_AQ + (l * 8 + xx) * 64; (void)lb; (void)BPX;
                for (;;) {
                    __syncthreads();
                    if (tid == 0) MISC[44] = __hip_atomic_fetch_add(aq, 1u, __ATOMIC_RELAXED, __HIP_MEMORY_SCOPE_AGENT);
                    __syncthreads();
                    const int li = __builtin_amdgcn_readfirstlane((int)MISC[44]);
                    if (li >= NUx_ML + NUx_SL + 2 * NUx_C) break;
                    int r = li;
                    if (r < NUx_ML) {
                        const int bh = (r >> 3) * NX + xx, qt = r & 7; const int b = bh >> 2, hh = bh & 3; const int row = b * SEQ + qt * 256;
                        attn_block<96>(lds, QM + (size_t)row * 384 + hh * 96, 384, KM + (size_t)(b * 4 + hh) * KT * 96, VMT + (size_t)(b * 4 + hh) * 64 * KT, 0, KT / 64, KT / 64, KT / 64,
                                       qt * 256, false, 0.10206207261596575f * L2E, false, 0.f, MIX + (size_t)row * D + 768 + hh * 64, tid);
                        continue; }
                    r -= NUx_ML;
                    if (r < NUx_SL) {
                        const int bk = (r >> 4) * NX + xx, hql = (r >> 3) & 1, qt = r & 7; const int b = bk >> 1, hk = bk & 1, hq = hk * 2 + hql; const int row = b * SEQ + qt * 256;
                        const int ja = (qt * 256 - 128) < 0 ? 0 : (qt * 256 - 128), jb = (qt * 256 + 384) > SEQ ? SEQ : (qt * 256 + 384);
                        attn_block<64>(lds, QA + (size_t)row * 256 + hq * 64, 256, KA + (size_t)(b * 2 + hk) * KT * 64, VAT + (size_t)(b * 2 + hk) * 64 * KT, 0, CL / 64, (CL + ja) / 64, (CL + jb) / 64,
                                       qt * 256, true, 0.125f * L2E, true, inp[I_SINK][l * 4 + hq] * L2E, MIX + (size_t)row * D + hq * 64, tid);
                        continue; }
                    r -= NUx_SL;
                    if (r < NUx_C) {
                        const int bk = (r >> 1) * NX + xx, hql = r & 1; const int b = bk >> 1, hk = bk & 1, hq = hk * 2 + hql; const int row = ML + b * CL;
                        attn_block<64>(lds, QA + (size_t)row * 256 + hq * 64, 256, KA + (size_t)(b * 2 + hk) * KT * 64, VAT + (size_t)(b * 2 + hk) * 64 * KT, 0, CL / 64, CL / 64, CL / 64,
                                       0, false, 0.125f * L2E, true, inp[I_SINK][l * 4 + hq] * L2E, MIX + (size_t)row * D + hq * 64, tid);
                        continue; }
                    r -= NUx_C;
                    {
                        const int bh = r * NX + xx; const int b = bh >> 2, hh = bh & 3; const int row = ML + b * CL;
                        attn_block<96>(lds, QM + (size_t)row * 384 + hh * 96, 384, KM + (size_t)(b * 4 + hh) * KT * 96, VMT + (size_t)(b * 4 + hh) * 64 * KT, 0, CL / 64, CL / 64, CL / 64,
                                       0, false, 0.10206207261596575f * L2E, false, 0.f, MIX + (size_t)row * D + 768 + hh * 64, tid);
                    }
                }
            }
        }
        SEAM(pb + 2);

        if (IN(pb + 3)) REPEAT(6) {
            PHASE_VIEW();
            WSP(bf16, OD, WS_OD); WSP(bf16, P, WS_P); WSP(bf16, MIX, WS_MIX);
            const float* gn = inp[I_GONORM] + l * 128;
            for (int it = gw; it < MROWS * 4; it += NGW) {
                const int row = it >> 2, hh = it & 3;
                const size_t oo = (size_t)row * 512 + hh * 128 + lane * 2;
                const unsigned of = *(const unsigned*)(OD + oo), ob = *(const unsigned*)(OD + (size_t)MT * 512 + oo); const float o0 = bflo(of) + bflo(ob), o1 = bfhi(of) + bfhi(ob);
                const float rs = rsqrtf(wave_sum(o0 * o0 + o1 * o1) * (1.f / 128.f) + EPS);
                const unsigned zz = *(const unsigned*)(P + (size_t)row * NINP + PC_GZ + hh * 128 + lane * 2);
                const float y0 = o0 * rs * gn[lane * 2] * siluf(bflo(zz)), y1 = o1 * rs * gn[lane * 2 + 1] * siluf(bfhi(zz));
                *(unsigned*)(MIX + (size_t)row * D + 256 + hh * 128 + lane * 2) = pk2(y0, y1);
            }
        }
        SEAM(pb + 3);

        if (IN(pb + 4)) {
            PHASE_VIEW();
            WSP(bf16, MIX, WS_MIX); WSP(bf16, WOUT, WS_WOUT); WSP(bf16, XW, WS_XW); WSP(float, MODV, WS_MODV);
            pg8::Gemm g{MIX, WOUT + (size_t)l * 1024 * 1024, MROWS, 1024, 1024}; pg8::StaticOrder S; S.init(MROWS, 1024, G, bid);
            pg8::EpiResid E{inp[I_X], inp[I_CTX], l == 0 ? (const bf16*)nullptr : XW, XW, MODV + (size_t)l * 17 * NMODC};
            pg8::gemm_phase<pg8::EpiResid, pg8::StaticOrder, true, true>(lds, g, S, E, wave0);
        }
        SEAM(pb + 4);

        if (IN(pb + 5)) REPEAT(8) {
            PHASE_VIEW();
            WSP(bf16, XW, WS_XW); WSP(bf16, H, WS_H); WSP(float, MODV, WS_MODV); WSP(int, PAIRE, WS_PAIRE); WSP(int, PAIRR, WS_PAIRR); WSP(float, PAIRG, WS_PAIRG);
            WSP(bf16, RWH, WS_RWH); WSP(bf16, RWL, WS_RWL);
            unsigned* cntw = (unsigned*)(wsb + WS_CTL) + CW_CNT + l * 32 * 64;
            const float* modv = MODV + (size_t)l * 17 * NMODC;
            constexpr int HSP = 1028;
            LAS float* hs = (LAS float*)lds;
            LAS float* part = (LAS float*)(lds + 66048);
            LAS int* lcount = (LAS int*)(lds + 82432);
            LAS int* lbase = (LAS int*)(lds + 82432 + 128);
            LAS int* tke = (LAS int*)(lds + 82688);
            LAS int* tkr = (LAS int*)(lds + 82688 + 10240);
            LAS float* tkg = (LAS float*)(lds + 82688 + 20480);
            const int per = (MROWS + G - 1) / G;
            const int t0 = bid * per, t1 = (t0 + per < MROWS) ? t0 + per : MROWS;
            __syncthreads();
            if (tid < 32) lcount[tid] = 0;
            const float* rb = inp[I_RB] + l * 32;
            const int c = lane & 15, g = lane >> 4;
            const bf16* rwh = RWH + (size_t)l * 32 * 1024; const bf16* rwl = RWL + (size_t)l * 32 * 1024;
            bf16x8_t rah[4][2], ral[4][2];
#pragma unroll
            for (int ks = 0; ks < 4; ++ks)
#pragma unroll
                for (int nb = 0; nb < 2; ++nb) { const size_t o = (size_t)(16 * nb + c) * 1024 + 128 * wave + 32 * ks + 8 * g; rah[ks][nb] = *(const bf16x8_t*)(rwh + o); ral[ks][nb] = *(const bf16x8_t*)(rwl + o); }
            v2u nvr[2][4];
#define G_LOADROWS(rd_) do { _Pragma("unroll") for (int q = 0; q < 2; ++q) { int row_ = (rd_) + wave * 2 + q; row_ = row_ < t1 ? row_ : t1 - 1; _Pragma("unroll") for (int j = 0; j < 4; ++j) nvr[q][j] = *(const v2u*)(XW + (size_t)row_ * D + j * 256 + lane * 4); } } while (0)
            G_LOADROWS(t0);
            for (int rd = t0; rd < t1; rd += 16) {
                __syncthreads();
#pragma unroll
                for (int q = 0; q < 2; ++q) {
                    const int tk = wave * 2 + q; const int row = rd + tk;
                    if (row < t1) {
                        const int b = (row < ML) ? row / SEQ : NB; const float* mv = modv + (size_t)b * NMODC;
                        f32x4 v[4]; float ss = 0.f;
                        f32x4 gn4[4], sh4[4], sc4[4];
#pragma unroll
                        for (int j = 0; j < 4; ++j) { const int idx = j * 256 + lane * 4; gn4[j] = *(const f32x4*)(inp[I_NORM2] + l * D + idx); sh4[j] = *(const f32x4*)(mv + 3 * D + idx); sc4[j] = *(const f32x4*)(mv + 4 * D + idx); }
                        asm volatile("" ::: "memory");
#pragma unroll
                        for (int j = 0; j < 4; ++j) { const v2u w_ = nvr[q][j]; v[j] = (f32x4){bflo(w_.x), bfhi(w_.x), bflo(w_.y), bfhi(w_.y)}; ss += (v[j].x * v[j].x + v[j].y * v[j].y) + (v[j].z * v[j].z + v[j].w * v[j].w); }
                        const float rstd = rsqrtf(wave_sum(ss) * (1.f / D) + EPS);
#pragma unroll
                        for (int j = 0; j < 4; ++j) { const int idx = j * 256 + lane * 4;
                            const f32x4 gn = gn4[j], sh = sh4[j], sc = sc4[j];
                            const f32x4 y = v[j] * rstd * gn * (sc + 1.f) + sh;
                            v2u o; o.x = pk2(y.x, y.y); o.y = pk2(y.z, y.w); *(v2u*)(H + (size_t)row * D + idx) = o;
                            *(LAS f32x4*)(hs + tk * HSP + idx) = y; }
                    } else { float z0 = 0.f; asm volatile("" : "+v"(z0));
#pragma unroll
                        for (int j = 0; j < 4; ++j) *(LAS f32x4*)(hs + tk * HSP + j * 256 + lane * 4) = (f32x4){z0, z0, z0, z0};
                    }
                }
                __syncthreads();
                if (rd + 16 < t1) G_LOADROWS(rd + 16);
                {
                    f32x4 acc[2] = {(f32x4){0.f, 0.f, 0.f, 0.f}, (f32x4){0.f, 0.f, 0.f, 0.f}};
#pragma unroll
                    for (int ks = 0; ks < 4; ++ks) { const int k0 = 128 * wave + 32 * ks + 8 * g;
                        const f32x4 h0 = *(const LAS f32x4*)(hs + c * HSP + k0), h1 = *(const LAS f32x4*)(hs + c * HSP + k0 + 4);
                        const float hv[8] = {h0.x, h0.y, h0.z, h0.w, h1.x, h1.y, h1.z, h1.w};
                        v4u whi, wlo; unsigned* ph = (unsigned*)&whi; unsigned* pl = (unsigned*)&wlo;
#pragma unroll
                        for (int j = 0; j < 8; j += 2) { const unsigned a = f2bf(hv[j]), b2 = f2bf(hv[j + 1]);
                            ph[j >> 1] = a | (b2 << 16);
                            pl[j >> 1] = pk2(hv[j] - __builtin_bit_cast(float, a << 16), hv[j + 1] - __builtin_bit_cast(float, b2 << 16)); }
                        const bf16x8_t bh = __builtin_bit_cast(bf16x8_t, whi), bl = __builtin_bit_cast(bf16x8_t, wlo);
#pragma unroll
                        for (int nb = 0; nb < 2; ++nb) { const bf16x8_t ah = rah[ks][nb], al = ral[ks][nb];
                            acc[nb] = __builtin_amdgcn_mfma_f32_16x16x32_bf16(ah, bh, acc[nb], 0, 0, 0);
                            acc[nb] = __builtin_amdgcn_mfma_f32_16x16x32_bf16(al, bh, acc[nb], 0, 0, 0);
                            acc[nb] = __builtin_amdgcn_mfma_f32_16x16x32_bf16(ah, bl, acc[nb], 0, 0, 0); } }
#pragma unroll
                    for (int nb = 0; nb < 2; ++nb) *(LAS f32x4*)(part + (wave * 16 + c) * 32 + 16 * nb + 4 * g) = acc[nb];
                }
                __syncthreads();
                {
                    const int tk = tid >> 5, e = tid & 31; const int row = rd + tk;
                    float lg = rb[e];
#pragma unroll
                    for (int w = 0; w < 8; ++w) lg += part[(w * 16 + tk) * 32 + e];
                    float vv = lg; int se[4]; float sl[4];
#pragma unroll
                    for (int kk = 0; kk < 4; ++kk) { float mx = vv;
#pragma unroll
                        for (int off = 16; off >= 1; off >>= 1) mx = fmaxf(mx, __shfl_xor(mx, off));
                        const unsigned long long bal = __ballot(vv == mx); const int ee = __ffs((unsigned)(bal >> (lane & 32))) - 1;
                        se[kk] = ee; sl[kk] = mx; if (e == ee) vv = -INFINITY; }
                    const float p1 = __expf(sl[1] - sl[0]), p2 = __expf(sl[2] - sl[0]), p3 = __expf(sl[3] - sl[0]); const float inv = 1.f / (1.f + p1 + p2 + p3);
                    if (e < 4 && row < t1) { const int ee = e == 0 ? se[0] : e == 1 ? se[1] : e == 2 ? se[2] : se[3];
                        const float gg = (e == 0 ? 1.f : e == 1 ? p1 : e == 2 ? p2 : p3) * inv;
                        const int lr = __hip_atomic_fetch_add(lcount + ee, 1, __ATOMIC_RELAXED, __HIP_MEMORY_SCOPE_WORKGROUP);
                        const int ti = row - t0; tke[ti * 4 + e] = ee; tkr[ti * 4 + e] = lr; tkg[ti * 4 + e] = gg; }
                }
            }
            __syncthreads();
#undef G_LOADROWS
            if (rep_ + 1 < nrep_) continue;
            if (tid < 32) lbase[tid] = (int)__hip_atomic_fetch_add(cntw + tid * 64, (unsigned)lcount[tid], __ATOMIC_RELAXED, __HIP_MEMORY_SCOPE_AGENT);
            __syncthreads();
            { WSP(int, TOKE, WS_TOKE); WSP(float, GATEE, WS_GATEE);
              for (int i = tid; i < (t1 - t0) * 4; i += NTHR) { const int ee = tke[i], rk = lbase[ee] + tkr[i]; PAIRE[(size_t)t0 * 4 + i] = ee; PAIRR[(size_t)t0 * 4 + i] = rk;
                  TOKE[(size_t)ee * MT + rk] = t0 + (i >> 2); GATEE[(size_t)ee * MT + rk] = tkg[i]; } }
        }
        SEAM(pb + 5);

        LAS int* tstart = (LAS int*)(lds + TAB_OFF);
        if (IN(pb + 6) || IN(pb + 7) || IN(pb + 8)) {
            PHASE_VIEW(); unsigned* cntw = (unsigned*)(wsb + WS_CTL) + CW_CNT + l * 32 * 64;
            __syncthreads();
            if (tid < NE) {
                const unsigned c = __hip_atomic_load(cntw + tid * 64, __ATOMIC_RELAXED, __HIP_MEMORY_SCOPE_AGENT); tstart[33 + tid] = (int)c;
                const int tiles = (int)((c + 255u) >> 8); int incl = tiles;
#pragma unroll
                for (int off = 1; off < NE; off <<= 1) { const int tv = __shfl_up(incl, off); if (tid >= off) incl += tv; }
                tstart[tid] = incl - tiles; if (tid == NE - 1) tstart[NE] = incl; }
            __syncthreads();
        }
        if (IN(pb + 6)) REPEAT(10) {
            PHASE_VIEW();
            WSP(bf16, H, WS_H); WSP(bf16, WGU, WS_WGU); WSP(bf16, ACT, WS_ACT); WSP(float, BGU, WS_BGU); WSP(int, TOK, WS_TOKE);
            pg8::Gemm g{H, WGU + (size_t)l * 32 * 2048 * 1024, 0, 0, 1024}; LAS unsigned short* rtab = (LAS unsigned short*)(lds + TAB_OFF + 512);
            pg8::MoeOrderT<true> S{tstart, tstart[NE], 8, G, bid, TOK, rtab}; S.preload(rtab, tid); __syncthreads();
            pg8::EpiSwiglu E{ACT, BGU + (size_t)l * 32 * 2048};
            pg8::gemm_phase<pg8::EpiSwiglu, pg8::MoeOrderT<true>, true, true>(lds, g, S, E, wave0, 1 + ((rep_mask >> 22) & 1));
        }
        SEAM(pb + 6);

        if (IN(pb + 7)) REPEAT(11) {
            PHASE_VIEW();
            WSP(bf16, ACT, WS_ACT); WSP(bf16, WDN, WS_WDN); WSP(bf16, Y, WS_Y); WSP(float, SLOTG, WS_GATEE);
            pg8::Gemm g{ACT, WDN + (size_t)l * 32 * 1024 * 1024, 0, 0, 1024}; pg8::MoeOrderT<false> S{tstart, tstart[NE], 4, G, bid, nullptr, nullptr};
            pg8::EpiDown E{Y, inp[I_BDN] + (size_t)l * 32 * 1024, SLOTG, tstart};
            pg8::gemm_phase<pg8::EpiDown, pg8::MoeOrderT<false>, true, true>(lds, g, S, E, wave0, 1 + ((rep_mask >> 22) & 1));
        }
        SEAM(pb + 7);

        if (IN(pb + 8)) for (int rep_ = 0, nrep_ = 1 + ((rep_mask >> 12) & l & 1); rep_ < nrep_; ++rep_) {
            PHASE_VIEW();
            WSP(bf16, XW, WS_XW); WSP(bf16, H, WS_H); WSP(bf16, Y, WS_Y); WSP(float, MODV, WS_MODV); WSP(int, PAIRE, WS_PAIRE); WSP(int, PAIRR, WS_PAIRR);
            for (int row = gw; row < MROWS; row += NGW) {
                const int b = (row < ML) ? row / SEQ : NB; const float* mv = MODV + ((size_t)l * 17 + b) * NMODC;
                f32x4 g5[4]; v2u xw[4];
#pragma unroll
                for (int j = 0; j < 4; ++j) { const int idx = j * 256 + lane * 4; g5[j] = *(const f32x4*)(mv + 5 * D + idx); xw[j] = *(const v2u*)(XW + (size_t)row * D + idx); }
                int pe[4], pr_[4];
#pragma unroll
                for (int k = 0; k < 4; ++k) { pe[k] = PAIRE[(size_t)row * 4 + k]; pr_[k] = PAIRR[(size_t)row * 4 + k]; }
                asm volatile("" ::: "memory");
                f32x4 y[4];
#pragma unroll
                for (int j = 0; j < 4; ++j) y[j] = (f32x4){0.f, 0.f, 0.f, 0.f};
                v2u yr[4][4];
#pragma unroll
                for (int k = 0; k < 4; ++k) { const int slot = tstart[pe[k]] * 256 + pr_[k];
#pragma unroll
                    for (int j = 0; j < 4; ++j) yr[k][j] = *(const v2u*)(Y + (size_t)slot * D + j * 256 + lane * 4); }
#pragma unroll
                for (int k = 0; k < 4; ++k)
#pragma unroll
                    for (int j = 0; j < 4; ++j) { const v2u w = yr[k][j]; y[j].x += bflo(w.x); y[j].y += bfhi(w.x); y[j].z += bflo(w.y); y[j].w += bfhi(w.y); }
                f32x4 v[4];
#pragma unroll
                for (int j = 0; j < 4; ++j) v[j] = (f32x4){bflo(xw[j].x), bfhi(xw[j].x), bflo(xw[j].y), bfhi(xw[j].y)} + g5[j] * y[j];
                if (l == 0) {
#pragma unroll
                    for (int j = 0; j < 4; ++j) { v2u o; o.x = pk2(v[j].x, v[j].y); o.y = pk2(v[j].z, v[j].w); *(v2u*)(XW + (size_t)row * D + j * 256 + lane * 4) = o; }
                    const float* mv1 = MODV + (size_t)(17 + b) * NMODC;
                    norm_mod_row(v, inp[I_NORM1] + D, mv1 + 0 * D, mv1 + 1 * D, H + (size_t)row * D, lane);
                } else {
#pragma unroll
                    for (int j = 0; j < 4; ++j) *(f32x4*)((*(float* const CAS*)(kap + offsetof(Args, out))) + (size_t)row * D + j * 256 + lane * 4) = v[j];
                }
            }
        }
        SEAM(pb + 8);
    }
#undef IN
#undef SEAM
}

extern "C" void kernel_launch(void* const* d_in, const int* in_sizes, int n_in, void* d_out, int out_size, void* d_ws, size_t ws_size, hipStream_t stream) {
    static int grid = 0;
    if (grid == 0) {
        if (n_in != 29 || out_size != ML * D || ws_size < WS_END) { fprintf(stderr, "kernel_launch: unexpected shapes (n_in %d, out %d, ws %zu < %zu)\n", n_in, out_size, ws_size, (size_t)WS_END); grid = -1; return; }
        int dev = 0, cus = 0, per_cu = 0;
        if (hipGetDevice(&dev) != hipSuccess || hipDeviceGetAttribute(&cus, hipDeviceAttributeMultiprocessorCount, dev) != hipSuccess) { grid = -1; return; }
        if (hipFuncSetAttribute((const void*)fwd, hipFuncAttributeMaxDynamicSharedMemorySize, LDS_BYTES) != hipSuccess) { fprintf(stderr, "kernel_launch: hipFuncSetAttribute failed\n"); grid = -1; return; }
        if (hipOccupancyMaxActiveBlocksPerMultiprocessor(&per_cu, (const void*)fwd, NTHR, LDS_BYTES) != hipSuccess || per_cu < 1) fprintf(stderr, "kernel_launch: occupancy query says %d\n", per_cu);
        (void)hipGetLastError();
        grid = cus > 256 ? 256 : cus;
        if (grid < 224 || (grid & 7)) { fprintf(stderr, "kernel_launch: this build needs a 224..256-CU device (multiple of 8), got %d\n", cus); grid = -1; return; }
    }
    if (grid < 0) return;
    (void)hipMemsetAsync((char*)d_ws + WS_CTL, 0, CTL_ZERO_BYTES, stream);
    Args a{};
    for (int i = 0; i < 29; ++i) a.in[i] = (const float*)d_in[i];
    a.out = (float*)d_out; a.ws = (unsigned char*)d_ws; a.rep_mask = PROBE_REP; a.pad = 0;
    constexpr int NPH = 20;
#if MK_PER_PHASE
    for (int p = 0; p < NPH; ++p) { a.ph_lo = p; a.ph_hi = p + 1; hipLaunchKernelGGL(fwd, dim3(grid), dim3(NTHR), LDS_BYTES, stream, a); }
#else
    a.ph_lo = 0; a.ph_hi = NPH; hipLaunchKernelGGL(fwd, dim3(grid), dim3(NTHR), LDS_BYTES, stream, a);
#endif
}
```
